# Optimizing an MI355X kernel written in HIP

```python
import math, functools
import jax, jax.numpy as jnp
from jax import lax
import numpy as np


D_MODEL = 1024
BATCH = 16
SEQ = 256
DEPTH = 4
DEC_BATCH = 2
DEC_SEQ = 1024
PAST_LEN = 512

GRID_W = 64
N_EVEN = (DEPTH + 1) // 2
N_ODD = DEPTH // 2
MIX_W = D_MODEL
HALF_W = MIX_W // 2
H_A = 4
DV_A = HALF_W // H_A
DK_A = DV_A // 2
GATE_RANK = 16
GLA_TAU = 16.0
GLA_CHUNK = 64
HD_B = 128
H_B = HALF_W // HD_B
KV_B = H_B // 2
HY_W = HALF_W
FILT_EMB = 33
FILT_BANDS = (FILT_EMB - 1) // 2
FILT_HID = 64
HY_MIN_DECAY = math.log(1e-2) / 1.5
HY_MAX_DECAY = math.log(1e-2) / 0.3
H_D = 4
V_D = HALF_W // H_D
NOPE_D = V_D
ROPE_D = NOPE_D // 2
Q_RANK = D_MODEL // 4
KV_RANK = D_MODEL // 8
FFN_H = -(-8 * D_MODEL // (3 * 256)) * 256
ROPE_THETA = 10000.0
Q_BLOCK = 128
EPS = 1e-6
EVEN_SIZES = [H_A * DK_A, H_A * DK_A, H_A * DV_A, H_A * DV_A, GATE_RANK, GATE_RANK, H_B * HD_B, KV_B * HD_B, KV_B * HD_B]
EVEN_SPLITS = [int(s) for s in np.cumsum(EVEN_SIZES)[:-1]]
IN_EVEN = sum(EVEN_SIZES)
ODD_SIZES = [3 * HY_W, Q_RANK, KV_RANK, ROPE_D]
ODD_SPLITS = [int(s) for s in np.cumsum(ODD_SIZES)[:-1]]
IN_ODD = sum(ODD_SIZES)

kernel_name = 'hybrid_diffusion_prefix_trunk_step'


def rms_norm(x, eps=EPS):
    xf = x.astype(jnp.float32)
    return (xf * lax.rsqrt(jnp.mean(xf * xf, axis=-1, keepdims=True) + eps)).astype(x.dtype)


def modulate(x, shift, scale):
    return rms_norm(x) * (1.0 + scale) + shift


def adaln(cvec, w_mod_l, b_mod_l):
    m = jax.nn.silu(cvec) @ w_mod_l + b_mod_l
    return jnp.split(m[:, None, :], 6, axis=-1)


def axial_rope_tables(n_tokens, dim):
    rows = n_tokens // GRID_W
    row = jnp.broadcast_to(jnp.arange(rows, dtype=jnp.float32)[:, None], (rows, GRID_W)).reshape(n_tokens)
    col = jnp.broadcast_to(jnp.arange(GRID_W, dtype=jnp.float32)[None, :], (rows, GRID_W)).reshape(n_tokens)
    n_freq = dim // 4
    inv = ROPE_THETA ** (-jnp.arange(n_freq, dtype=jnp.float32) / n_freq)
    ang = jnp.concatenate([row[:, None] * inv, col[:, None] * inv], axis=-1)
    return jnp.cos(ang), jnp.sin(ang)


def apply_rope(x, cos, sin):
    x1, x2 = jnp.split(x, 2, axis=-1)
    c = cos[None, :, None, :]
    s = sin[None, :, None, :]
    return jnp.concatenate([x1 * c - x2 * s, x1 * s + x2 * c], axis=-1).astype(x.dtype)


def block_attention(q, k, v, scale):
    B, Lq, H, dq = q.shape
    G = k.shape[2]
    rep = H // G
    dv = v.shape[-1]
    nb = Lq // Q_BLOCK
    qb = q.reshape(B, nb, Q_BLOCK, G, rep, dq).transpose(1, 0, 2, 3, 4, 5)

    def attend(qi):
        s = jnp.einsum('bqgrd,bkgd->bgrqk', qi, k, preferred_element_type=jnp.float32) * scale
        p = jax.nn.softmax(s, axis=-1).astype(v.dtype)
        return jnp.einsum('bgrqk,bkge->bqgre', p, v)

    o = lax.map(attend, qb)
    return o.transpose(1, 0, 2, 3, 4, 5).reshape(B, Lq, H, dv)


def gla_chunked(q, k, v, log_a, s0):
    B, L, H, dk = q.shape
    dv = v.shape[-1]
    n_chunks = L // GLA_CHUNK

    def chunks(t):
        return t.astype(jnp.float32).reshape(B, n_chunks, GLA_CHUNK, H, t.shape[-1]).transpose(1, 0, 3, 2, 4)

    xs = (chunks(q * dk ** -0.5), chunks(k), chunks(v), chunks(log_a))
    causal = jnp.tril(jnp.ones((GLA_CHUNK, GLA_CHUNK), dtype=bool))[:, :, None]

    def step(state, inp):
        qc, kc, vc, ac = inp
        b = jnp.cumsum(ac, axis=2)
        diff = b[:, :, :, None, :] - b[:, :, None, :, :]
        decay = jnp.exp(jnp.where(causal, diff, -jnp.inf))
        scores = jnp.einsum('bhid,bhjd,bhijd->bhij', qc, kc, decay)
        o = jnp.einsum('bhij,bhje->bhie', scores, vc) + jnp.einsum('bhid,bhde->bhie', qc * jnp.exp(b), state)
        b_last = b[:, :, -1:, :]
        new_state = state * jnp.exp(b_last[:, :, 0, :])[..., None] + jnp.einsum('bhjd,bhje->bhde', kc * jnp.exp(b_last - b), vc)
        return new_state, o

    s_fin, o = lax.scan(step, s0.astype(jnp.float32), xs)
    return o.transpose(1, 0, 3, 2, 4).reshape(B, L, H, dv), s_fin


def short_conv3(x, w, b):
    xp = jnp.pad(x, ((0, 0), (1, 1), (0, 0)))
    return xp[:, :-2] * w[0] + xp[:, 1:-1] * w[1] + xp[:, 2:] * w[2] + b


def implicit_filters(n_tokens, wf1, bf1, freq, wf2, bf2, wf3):
    t = jnp.linspace(0.0, 1.0, n_tokens, dtype=jnp.float32)[:, None]
    w = 2.0 * math.pi * jnp.arange(n_tokens, dtype=jnp.float32)[:, None] / n_tokens
    f = jnp.linspace(1e-4, FILT_BANDS - 1, FILT_BANDS, dtype=jnp.float32)[None, :]
    z = jnp.concatenate([t, jnp.cos(f * w), -jnp.sin(f * w)], axis=-1).astype(wf1.dtype)
    hid = jnp.sin(freq * (z @ wf1 + bf1))
    hid = jnp.sin(freq * (hid @ wf2 + bf2))
    filt = (hid @ wf3).astype(jnp.float32)
    deltas = jnp.abs(jnp.linspace(HY_MIN_DECAY, HY_MAX_DECAY, HY_W, dtype=jnp.float32))
    decay = jnp.exp(-t * deltas)
    return filt * jnp.concatenate([decay, decay], axis=-1)


def long_conv_bidir(u, filt):
    L = u.shape[1]
    n = 2 * L
    h_f, h_b = jnp.split(filt, 2, axis=-1)
    g = jnp.concatenate([h_f, jnp.zeros((1, HY_W), jnp.float32), jnp.flip(h_b[1:], axis=0)], axis=0)
    G = jnp.fft.rfft(g, axis=0)
    U = jnp.fft.rfft(u.astype(jnp.float32), n=n, axis=1)
    y = jnp.fft.irfft(U * G[None], n=n, axis=1)[:, :L]
    return y.astype(u.dtype)


def swiglu(h, w_in, w_out):
    g, u = jnp.split(h @ w_in, 2, axis=-1)
    return (jax.nn.silu(g) * u) @ w_out


def even_mixer(h, w_in, w_gf, b_gf, w_gb, b_gb, g_norm, g_q, g_k, w_out, ctx=None, rope=None):
    B, L, _ = h.shape
    q_a, k_a, v_a, r_a, z_f, z_b, q_g, k_g, v_g = jnp.split(h @ w_in, EVEN_SPLITS, axis=-1)
    q_a = q_a.reshape(B, L, H_A, DK_A)
    k_a = k_a.reshape(B, L, H_A, DK_A)
    v_a = v_a.reshape(B, L, H_A, DV_A)
    log_f = (jax.nn.log_sigmoid((z_f @ w_gf + b_gf).astype(jnp.float32)) / GLA_TAU).reshape(B, L, H_A, DK_A)
    log_b = (jax.nn.log_sigmoid((z_b @ w_gb + b_gb).astype(jnp.float32)) / GLA_TAU).reshape(B, L, H_A, DK_A)
    if ctx is None:
        s_f0 = jnp.zeros((B, H_A, DK_A, DV_A), jnp.float32)
        s_b0 = jnp.zeros((B, H_A, DK_A, DV_A), jnp.float32)
    else:
        s_f0, s_b0 = ctx[0], ctx[1]
    o_fw, s_f = gla_chunked(q_a, k_a, v_a, log_f, s_f0)
    o_bw, s_b = gla_chunked(jnp.flip(q_a, 1), jnp.flip(k_a, 1), jnp.flip(v_a, 1), jnp.flip(log_b, 1), s_b0)
    o_bw = jnp.flip(o_bw, 1)
    o_a = (rms_norm(o_fw + o_bw) * g_norm).astype(h.dtype) * jax.nn.silu(r_a).reshape(B, L, H_A, DV_A)
    o_a = o_a.reshape(B, L, HALF_W)
    q_g = rms_norm(q_g.reshape(B, L, H_B, HD_B)) * g_q
    k_g = rms_norm(k_g.reshape(B, L, KV_B, HD_B)) * g_k
    v_g = v_g.reshape(B, L, KV_B, HD_B)
    if ctx is None:
        keys, vals = k_g, v_g
        new_state = (s_f, s_b, k_g, v_g)
    else:
        cos, sin = rope
        q_g = apply_rope(q_g, cos, sin)
        keys = jnp.concatenate([ctx[2].astype(h.dtype), apply_rope(k_g, cos, sin)], axis=1)
        vals = jnp.concatenate([ctx[3].astype(h.dtype), v_g], axis=1)
        new_state = None
    o_g = block_attention(q_g, keys, vals, HD_B ** -0.5).reshape(B, L, HALF_W)
    return jnp.concatenate([o_a, o_g], axis=-1) @ w_out, new_state


def odd_mixer(h, w_in, w_conv, b_conv, skip, wf1, bf1, freq, wf2, bf2, wf3, g_q, w_qb, g_kv, w_kvb, w_out, ctx=None, rope=None):
    B, L, _ = h.shape
    u_hy, cq, ckv, kpe = jnp.split(h @ w_in, ODD_SPLITS, axis=-1)
    x0, x1, v = jnp.split(short_conv3(u_hy, w_conv, b_conv), 3, axis=-1)
    filt = implicit_filters(L, wf1, bf1, freq, wf2, bf2, wf3)
    gv = x1 * v
    y_hy = x0 * (long_conv_bidir(gv, filt) + gv * skip)
    q = ((rms_norm(cq) * g_q) @ w_qb).reshape(B, L, H_D, NOPE_D + ROPE_D)
    q_nope, q_pe = jnp.split(q, [NOPE_D], axis=-1)
    ckv = rms_norm(ckv) * g_kv
    if ctx is None:
        ckv_all, kpe_all = ckv, kpe
        new_state = (ckv, kpe)
    else:
        cos, sin = rope
        q_pe = apply_rope(q_pe, cos, sin)
        kpe_lat = apply_rope(kpe[:, :, None, :], cos, sin)[:, :, 0, :]
        ckv_all = jnp.concatenate([ctx[0].astype(h.dtype), ckv], axis=1)
        kpe_all = jnp.concatenate([ctx[1].astype(h.dtype), kpe_lat], axis=1)
        new_state = None
    Lk = ckv_all.shape[1]
    kv = (ckv_all @ w_kvb).reshape(B, Lk, H_D, NOPE_D + V_D)
    k_nope, vals = jnp.split(kv, [NOPE_D], axis=-1)
    keys = jnp.concatenate([k_nope, jnp.broadcast_to(kpe_all[:, :, None, :], (B, Lk, H_D, ROPE_D))], axis=-1)
    qf = jnp.concatenate([q_nope, q_pe], axis=-1)
    o_d = block_attention(qf, keys, vals, (NOPE_D + ROPE_D) ** -0.5).reshape(B, L, HALF_W)
    return jnp.concatenate([y_hy, o_d], axis=-1) @ w_out, new_state


def setup_inputs(seed: int = 0) -> dict:
    key = jax.random.key(seed)
    ks = iter(jax.random.split(key, 64))

    def nrm(shape, scale):
        return jax.random.normal(next(ks), shape, jnp.float32) * scale

    def gain(shape):
        return 1.0 + nrm(shape, 0.05)

    d = D_MODEL
    return {
        'x_prompt': nrm((BATCH, SEQ, d), 1.0),
        'x_sample': nrm((DEC_BATCH, DEC_SEQ, d), 1.0),
        'state_gla_fwd': nrm((DEC_BATCH, N_EVEN, H_A, DK_A, DV_A), 0.5),
        'state_gla_bwd': nrm((DEC_BATCH, N_EVEN, H_A, DK_A, DV_A), 0.5),
        'cache_gqa_k': nrm((DEC_BATCH, N_EVEN, PAST_LEN, KV_B, HD_B), 1.0),
        'cache_gqa_v': nrm((DEC_BATCH, N_EVEN, PAST_LEN, KV_B, HD_B), 1.0),
        'cache_mla_ckv': nrm((DEC_BATCH, N_ODD, PAST_LEN, KV_RANK), 1.0),
        'cache_mla_kpe': nrm((DEC_BATCH, N_ODD, PAST_LEN, ROPE_D), 1.0),
        'c': nrm((DEC_BATCH, d), 1.0),
        'c_ctx': nrm((d,), 1.0),
        'w_mod': nrm((DEPTH, d, 6 * d), 0.5 * d ** -0.5),
        'b_mod': nrm((DEPTH, 6 * d), 0.02),
        'w_in_even': nrm((N_EVEN, d, IN_EVEN), d ** -0.5),
        'w_gla_gate_f': nrm((N_EVEN, GATE_RANK, H_A * DK_A), GATE_RANK ** -0.5),
        'b_gla_gate_f': nrm((N_EVEN, H_A * DK_A), 0.1),
        'w_gla_gate_b': nrm((N_EVEN, GATE_RANK, H_A * DK_A), GATE_RANK ** -0.5),
        'b_gla_gate_b': nrm((N_EVEN, H_A * DK_A), 0.1),
        'g_gla_norm': gain((N_EVEN, DV_A)),
        'g_gqa_q': gain((N_EVEN, HD_B)),
        'g_gqa_k': gain((N_EVEN, HD_B)),
        'w_out_even': nrm((N_EVEN, MIX_W, d), MIX_W ** -0.5),
        'w_in_odd': nrm((N_ODD, d, IN_ODD), d ** -0.5),
        'w_hy_conv': nrm((N_ODD, 3, 3 * HY_W), 3 ** -0.5),
        'b_hy_conv': nrm((N_ODD, 3 * HY_W), 0.02),
        'hy_skip': nrm((N_ODD, HY_W), 0.5),
        'w_filt1': nrm((N_ODD, FILT_EMB, FILT_HID), FILT_EMB ** -0.5),
        'b_filt1': nrm((N_ODD, FILT_HID), 0.02),
        'filt_freq': gain((N_ODD, FILT_HID)),
        'w_filt2': nrm((N_ODD, FILT_HID, FILT_HID), FILT_HID ** -0.5),
        'b_filt2': nrm((N_ODD, FILT_HID), 0.02),
        'w_filt3': nrm((N_ODD, FILT_HID, 2 * HY_W), 0.1 * FILT_HID ** -0.5),
        'g_mla_q': gain((N_ODD, Q_RANK)),
        'w_mla_qb': nrm((N_ODD, Q_RANK, H_D * (NOPE_D + ROPE_D)), Q_RANK ** -0.5),
        'g_mla_kv': gain((N_ODD, KV_RANK)),
        'w_mla_kvb': nrm((N_ODD, KV_RANK, H_D * (NOPE_D + V_D)), KV_RANK ** -0.5),
        'w_out_odd': nrm((N_ODD, MIX_W, d), MIX_W ** -0.5),
        'w_ffn_in': nrm((DEPTH, d, 2 * FFN_H), d ** -0.5),
        'w_ffn_out': nrm((DEPTH, FFN_H, d), FFN_H ** -0.5),
        'g_final': gain((d,)),
    }


def reference(x_prompt, x_sample, state_gla_fwd, state_gla_bwd, cache_gqa_k, cache_gqa_v, cache_mla_ckv, cache_mla_kpe,
              c, c_ctx, w_mod, b_mod, w_in_even, w_gla_gate_f, b_gla_gate_f, w_gla_gate_b, b_gla_gate_b, g_gla_norm,
              g_gqa_q, g_gqa_k, w_out_even, w_in_odd, w_hy_conv, b_hy_conv, hy_skip, w_filt1, b_filt1, filt_freq,
              w_filt2, b_filt2, w_filt3, g_mla_q, w_mla_qb, g_mla_kv, w_mla_kvb, w_out_odd, w_ffn_in, w_ffn_out, g_final):
    L_s = x_sample.shape[1]
    rope_b = axial_rope_tables(L_s, HD_B)
    rope_d = axial_rope_tables(L_s, ROPE_D)
    c_pre = c_ctx[None, :]
    xc, xs = x_prompt, x_sample
    st_gf, st_gb, st_k, st_v, st_ckv, st_kpe = [], [], [], [], [], []
    for i in range(DEPTH):
        mc = adaln(c_pre, w_mod[i], b_mod[i])
        ms = adaln(c, w_mod[i], b_mod[i])
        hc = modulate(xc, mc[0], mc[1])
        hs = modulate(xs, ms[0], ms[1])
        if i % 2 == 0:
            j = i // 2
            mixer = functools.partial(even_mixer, w_in=w_in_even[j], w_gf=w_gla_gate_f[j], b_gf=b_gla_gate_f[j],
                                      w_gb=w_gla_gate_b[j], b_gb=b_gla_gate_b[j], g_norm=g_gla_norm[j],
                                      g_q=g_gqa_q[j], g_k=g_gqa_k[j], w_out=w_out_even[j])
            oc, st = mixer(hc)
            os_, _ = mixer(hs, ctx=(state_gla_fwd[:, j], state_gla_bwd[:, j], cache_gqa_k[:, j], cache_gqa_v[:, j]), rope=rope_b)
            st_gf.append(st[0])
            st_gb.append(st[1])
            st_k.append(st[2])
            st_v.append(st[3])
        else:
            j = i // 2
            mixer = functools.partial(odd_mixer, w_in=w_in_odd[j], w_conv=w_hy_conv[j], b_conv=b_hy_conv[j],
                                      skip=hy_skip[j], wf1=w_filt1[j], bf1=b_filt1[j], freq=filt_freq[j],
                                      wf2=w_filt2[j], bf2=b_filt2[j], wf3=w_filt3[j], g_q=g_mla_q[j],
                                      w_qb=w_mla_qb[j], g_kv=g_mla_kv[j], w_kvb=w_mla_kvb[j], w_out=w_out_odd[j])
            oc, st = mixer(hc)
            os_, _ = mixer(hs, ctx=(cache_mla_ckv[:, j], cache_mla_kpe[:, j]), rope=rope_d)
            st_ckv.append(st[0])
            st_kpe.append(st[1])
        xc = xc + mc[2] * oc
        xs = xs + ms[2] * os_
        xc = xc + mc[5] * swiglu(modulate(xc, mc[3], mc[4]), w_ffn_in[i], w_ffn_out[i])
        xs = xs + ms[5] * swiglu(modulate(xs, ms[3], ms[4]), w_ffn_in[i], w_ffn_out[i])
    y_prompt = rms_norm(xc) * g_final
    y_sample = rms_norm(xs) * g_final
    new_state_gla_fwd = jnp.stack(st_gf, axis=1)
    new_state_gla_bwd = jnp.stack(st_gb, axis=1)
    new_cache_gqa_k = jnp.stack(st_k, axis=1)
    new_cache_gqa_v = jnp.stack(st_v, axis=1)
    new_cache_mla_ckv = jnp.stack(st_ckv, axis=1)
    new_cache_mla_kpe = jnp.stack(st_kpe, axis=1)
    return (y_prompt, y_sample, new_state_gla_fwd, new_state_gla_bwd, new_cache_gqa_k, new_cache_gqa_v, new_cache_mla_ckv, new_cache_mla_kpe)
```

```cpp
#include <hip/hip_runtime.h>
#include <hip/hip_cooperative_groups.h>
#include <cstdio>
namespace cg = cooperative_groups;

#ifndef REP_KIND
#define REP_KIND -1
#endif
#ifndef REP_VAR
#define REP_VAR -1
#endif
#ifndef REP_N
#define REP_N 0
#endif
#ifndef REP_SUB
#define REP_SUB 0
#endif
#ifndef USE_CG_SYNC
#define USE_CG_SYNC 0
#endif
#ifndef EXTRA_SYNC
#define EXTRA_SYNC 0
#endif
#ifndef MULTI_LAUNCH
#define MULTI_LAUNCH 0
#endif

#define LAS __attribute__((address_space(3)))
typedef unsigned short bf16_t;
typedef short bf16x8 __attribute__((ext_vector_type(8)));
typedef float f32x4 __attribute__((ext_vector_type(4)));
typedef float f32x16 __attribute__((ext_vector_type(16)));
typedef unsigned u32x4 __attribute__((ext_vector_type(4)));
typedef unsigned u32x2 __attribute__((ext_vector_type(2)));

constexpr int T = 6144, TK = 7168;
constexpr int NIN = 39;
constexpr float EPS = 1e-6f;
constexpr int N_PHASES = 36;

constexpr size_t O_YP = 0, O_YS = 4194304, O_SF = 6291456, O_SB = 7340032, O_CK = 8388608, O_CV = 10485760, O_CKV = 12582912, O_KPE = 13631488;

constexpr size_t al256(size_t x) { return (x + 255) & ~(size_t)255; }
constexpr size_t WS_X = 0;
constexpr size_t WS_H = WS_X + al256((size_t)T * 1024 * 4);
constexpr size_t WS_MOD = WS_H + al256((size_t)T * 1024 * 2);
constexpr size_t WS_PROJ = WS_MOD + al256((size_t)4 * 3 * 6144 * 4);
constexpr size_t WS_ZG = WS_PROJ + al256((size_t)T * 2560 * 2);
constexpr size_t WS_WZ = WS_ZG + al256((size_t)T * 32 * 4);
constexpr size_t WS_MIX = WS_WZ + al256((size_t)2 * 32 * 1024 * 2);
constexpr size_t WS_ACT = WS_MIX + al256((size_t)T * 1024 * 2);
constexpr size_t WS_WINE = WS_ACT + al256((size_t)T * 2816 * 2);
constexpr size_t WS_WOUTE = WS_WINE + al256((size_t)2 * 2560 * 1024 * 2);
constexpr size_t WS_WINO = WS_WOUTE + al256((size_t)2 * 1024 * 1024 * 2);
constexpr size_t WS_WOUTO = WS_WINO + al256((size_t)2 * 2048 * 1024 * 2);
constexpr size_t WS_WQB = WS_WOUTO + al256((size_t)2 * 1024 * 1024 * 2);
constexpr size_t WS_WKVK = WS_WQB + al256((size_t)2 * 768 * 256 * 2);
constexpr size_t WS_WKVV = WS_WKVK + al256((size_t)2 * 512 * 256 * 2);
constexpr size_t WS_WFI = WS_WKVV + al256((size_t)2 * 512 * 256 * 2);
constexpr size_t WS_WFO = WS_WFI + al256((size_t)4 * 5632 * 1024 * 2);
constexpr size_t WS_DS = WS_WFO + al256((size_t)4 * 1024 * 2816 * 2);
constexpr size_t WS_DEC = WS_DS + al256((size_t)768 * 64 * 128 * 4);
constexpr size_t WS_QNG = WS_DEC + al256((size_t)768 * 64 * 4);
constexpr size_t WS_KNG = WS_QNG + al256((size_t)T * 512 * 2);
constexpr size_t WS_VTG = WS_KNG + al256((size_t)TK * 256 * 2);
constexpr size_t WS_GR = WS_VTG + al256((size_t)256 * TK * 2);
constexpr size_t WS_X0 = WS_GR + al256((size_t)2 * 512 * 2560 * 2);
constexpr size_t WS_GV = WS_X0 + al256((size_t)T * 512 * 2);
constexpr size_t WS_GVT = WS_GV + al256((size_t)T * 512 * 2);
constexpr size_t WS_CQN = WS_GVT + al256((size_t)512 * T * 2);
constexpr size_t WS_CKV = WS_CQN + al256((size_t)T * 256 * 2);
constexpr size_t WS_KPE = WS_CKV + al256((size_t)2 * TK * 256 * 2);
constexpr size_t WS_QMLA = WS_KPE + al256((size_t)2 * TK * 64 * 2);
constexpr size_t WS_KNOPE = WS_QMLA + al256((size_t)T * 768 * 2);
constexpr size_t WS_VTM = WS_KNOPE + al256((size_t)TK * 512 * 2);
constexpr size_t WS_BAR = WS_VTM + al256((size_t)512 * TK * 2);
constexpr size_t WS_P = WS_BAR + 16384;
constexpr size_t WS_END = WS_P + al256((size_t)2 * T * 1024 * 2);

constexpr int LDS_BYTES = 139264;

struct Params {
    const float* in[NIN];
    float* out;
    unsigned char* ws;
    int ph_lo, ph_hi;
};

typedef const __attribute__((address_space(4))) Params& PRef;
typedef const __attribute__((address_space(4))) Params* PPtr;
__device__ __forceinline__ PPtr get_params() { PPtr q = (PPtr)__builtin_amdgcn_kernarg_segment_ptr(); asm volatile("" : "+s"(q)); return q; }

__device__ __forceinline__ int tidx() { int t = (int)__builtin_amdgcn_workitem_id_x(); asm volatile("" : "+v"(t)); return t; }
__device__ __forceinline__ int bidx() { int t = (int)__builtin_amdgcn_workgroup_id_x(); asm volatile("" : "+s"(t)); return t; }
__device__ __forceinline__ int gdim() { int t = (int)__ockl_get_num_groups(0); asm volatile("" : "+s"(t)); return t; }
__device__ __forceinline__ bf16_t f2bf(float f) { unsigned u = __float_as_uint(f); u += 0x7FFFu + ((u >> 16) & 1u); return (bf16_t)(u >> 16); }
__device__ __forceinline__ float bf2f(bf16_t b) { return __uint_as_float(((unsigned)b) << 16); }
typedef __bf16 bf16v2_t __attribute__((ext_vector_type(2)));
typedef float f32v2_t __attribute__((ext_vector_type(2)));
__device__ __forceinline__ unsigned pk2(float lo, float hi) { f32v2_t v; v[0] = lo; v[1] = hi; return __builtin_bit_cast(unsigned, __builtin_convertvector(v, bf16v2_t)); }
__device__ __forceinline__ float wave_sum(float v) {
#pragma unroll
    for (int o = 32; o > 0; o >>= 1) v += __shfl_xor(v, o, 64);
    return v;
}
__device__ __forceinline__ float silu_f(float g) { return g * __builtin_amdgcn_rcpf(1.0f + __expf(-g)); }
__device__ __forceinline__ int cvec_of(int r) { return r < 4096 ? 0 : 1 + ((r - 4096) >> 10); }
__device__ __forceinline__ f32x16 zero16() { f32x16 z;
#pragma unroll
    for (int i = 0; i < 16; ++i) z[i] = 0.f; return z; }
__device__ __forceinline__ f32x16 mfma32(bf16x8 a, bf16x8 b, f32x16 c) { return __builtin_amdgcn_mfma_f32_32x32x16_bf16(a, b, c, 0, 0, 0); }
__device__ __forceinline__ f32x16 mma_rows(const bf16_t* A, int lda, const bf16_t* B, int ldb, int K, f32x16 acc) {
    const int lane = tidx() & 63, r = lane & 31, h = lane >> 5;
    for (int k0 = 0; k0 < K; k0 += 16) {
        bf16x8 a = *(const bf16x8*)(A + r * lda + k0 + 8 * h);
        bf16x8 b = *(const bf16x8*)(B + r * ldb + k0 + 8 * h);
        acc = mfma32(a, b, acc);
    }
    return acc;
}

namespace pg8 {
constexpr int BM = 256, BK = 64, HALF = 128, HTB = HALF * BK * 2, STAGE_BYTES = 8 * HTB, NXCD = 8, WGM = 8;
__device__ __forceinline__ int lds_byte(int r, int c) { const int st = (r >> 4) * 2 + (c >> 5), rr = r & 15, cc = c & 31, ob = rr * 64 + cc * 2; return st * 1024 + (ob ^ (((ob >> 9) & 1) << 5)); }
__device__ __forceinline__ void stage_rc(int b, int& R, int& C) { const int st = b / 1024, sb = b % 1024, swz = sb ^ (((sb >> 9) & 1) << 5); R = (st >> 1) * 16 + swz / 64; C = (st & 1) * 32 + (swz % 64) / 2; }
__device__ __forceinline__ int perm32(int rho) { const int n = rho >> 4, i = rho & 15; return 8 * (i >> 2) + 4 * n + (i & 3); }
struct Unit { int pm, pn, sp, ko; };
struct Gemm { const bf16_t* A; const bf16_t* Bt; int M, N, K, ld; };
struct Order {
    int nM, nN, nwg, G, c, ns, ksub;
    __device__ void init(int M, int N, int G_, int c_, int ns_ = 1, int ksub_ = 0) { nM = M / BM; nN = N / BM; nwg = nM * nN; G = G_; c = c_; ns = ns_; ksub = ksub_; }
    __device__ bool next(int i, Unit& u) const {
        if (c < 0) return false;
        const long L = (long)i * G + c; if (L >= (long)nwg * ns) return false;
        const int sp = (int)(L / nwg);
        int wgid = (int)(L % nwg); { const int q = nwg / NXCD, r = nwg % NXCD, xcd = wgid % NXCD, off = wgid / NXCD; wgid = (xcd < r ? xcd * (q + 1) : r * (q + 1) + (xcd - r) * q) + off; }
        const int nig = WGM * nN, gid = wgid / nig, fm = gid * WGM, gsz = (nM - fm) < WGM ? (nM - fm) : WGM;
        u.pm = fm + ((wgid % nig) % gsz); u.pn = (wgid % nig) / gsz; u.sp = sp; u.ko = sp * ksub; return true;
    }
};

template <class Epi>
__device__ __forceinline__ void gemm_phase(LAS unsigned char* lds, const Gemm g, const Order& S, const Epi& E) {
    const int tid = tidx(), wid = __builtin_amdgcn_readfirstlane(tid >> 6), lane = tid & 63, wr = wid >> 2, wc = wid & 3, fr = lane & 15, fq = lane >> 4;
    const int K = g.ld, nt = g.K / BK;
    unsigned voffA[2], voffB[2];
#pragma unroll
    for (int i = 0; i < 2; ++i) { int R, C; stage_rc(tid * 16 + i * 8192, R, C); const int Rb = Epi::PERM ? ((R & ~31) + perm32(R & 31)) : R;
        voffA[i] = (unsigned)(R * K + C) * 2u; voffB[i] = (unsigned)(Rb * K + C) * 2u; }
    const size_t kstep = (size_t)(BK * 2);
    const size_t hstep = (size_t)HALF * K * 2;
    const size_t tstep = 2 * hstep;
    const unsigned ldsw = (unsigned)wid * 1024u;
    const int aoff = lds_byte(wr * 64 + fr, fq * 8), boff = lds_byte(wc * 32 + fr, fq * 8);
#define PG8_SA(b, h) (((b) * 2 + (h)) * HTB)
#define PG8_SB(b, h) ((4 + (b) * 2 + (h)) * HTB)
#define PG8_STAGE(bufoff, gbase, voff) do { _Pragma("unroll") for (int _i = 0; _i < 2; ++_i) \
        __builtin_amdgcn_global_load_lds((const unsigned*)((const char*)(gbase) + (voff)[_i]), (LAS unsigned*)(lds + (bufoff) + ldsw + _i * 8192), 16, 0, 0); } while (0)
#define PG8_LDA(dst, b, h) do { _Pragma("unroll") for (int m = 0; m < 4; ++m) _Pragma("unroll") for (int k = 0; k < 2; ++k) dst[m][k] = *(const LAS bf16x8*)(lds + PG8_SA(b, h) + aoff + m * 2048 + k * 1024); } while (0)
#define PG8_LDB(dst, b, h) do { _Pragma("unroll") for (int n = 0; n < 2; ++n) _Pragma("unroll") for (int k = 0; k < 2; ++k) dst[n][k] = *(const LAS bf16x8*)(lds + PG8_SB(b, h) + boff + n * 2048 + k * 1024); } while (0)
#define PG8_MMA(ai, bj, At, Bt) do { __builtin_amdgcn_s_setprio(1); _Pragma("unroll") for (int m = 0; m < 4; ++m) _Pragma("unroll") for (int n = 0; n < 2; ++n) _Pragma("unroll") for (int k = 0; k < 2; ++k) \
        acc[ai][bj][m][n] = __builtin_amdgcn_mfma_f32_16x16x32_bf16(Bt[n][k], At[m][k], acc[ai][bj][m][n], 0, 0, 0); __builtin_amdgcn_s_setprio(0); } while (0)
#define PG8_WAIT_V(n) asm volatile("s_waitcnt vmcnt(" #n ")" ::: "memory")
#define PG8_WAIT_L(n) asm volatile("s_waitcnt lgkmcnt(" #n ")" ::: "memory")
#define PG8_BAR __builtin_amdgcn_s_barrier()
#define PG8_SCHED __builtin_amdgcn_sched_barrier(0)
    Unit cur, nxt; int ui = 0;
    if (!S.next(0, cur)) return;
    f32x4 acc[2][2][4][2];
#pragma unroll
    for (int a = 0; a < 2; ++a)
#pragma unroll
        for (int b = 0; b < 2; ++b)
#pragma unroll
            for (int m = 0; m < 4; ++m)
#pragma unroll
                for (int n = 0; n < 2; ++n) acc[a][b][m][n] = (f32x4){0.f, 0.f, 0.f, 0.f};
    bf16x8 At[4][2], B0[2][2], B1[2][2];
    const char* cA = (const char*)g.A + (size_t)cur.pm * tstep + (size_t)cur.ko * 2; const char* cB = (const char*)g.Bt + (size_t)cur.pn * tstep + (size_t)cur.ko * 2;
    PG8_STAGE(PG8_SB(0, 0), cB, voffB); PG8_STAGE(PG8_SA(0, 0), cA, voffA); PG8_STAGE(PG8_SB(0, 1), cB + hstep, voffB); PG8_STAGE(PG8_SA(0, 1), cA + hstep, voffA);
    if (wr == 1) PG8_BAR;
    PG8_WAIT_V(4); PG8_BAR;
    PG8_STAGE(PG8_SB(1, 0), cB + kstep, voffB); PG8_STAGE(PG8_SA(1, 0), cA + kstep, voffA); PG8_STAGE(PG8_SB(1, 1), cB + hstep + kstep, voffB);
    PG8_WAIT_V(6); PG8_BAR;
    for (;;) {
        const bool has_next = S.next(ui + 1, nxt);
        const char* nA = has_next ? (const char*)g.A + (size_t)nxt.pm * tstep + (size_t)nxt.ko * 2 : cA; const char* nB = has_next ? (const char*)g.Bt + (size_t)nxt.pn * tstep + (size_t)nxt.ko * 2 : cB;
        for (int t = 0; t < nt; t += 2) {
            const bool last = (t == nt - 2);
            const char* a1 = cA + (size_t)(t + 1) * kstep;
            const char* a2 = last ? nA : cA + (size_t)(t + 2) * kstep; const char* b2 = last ? nB : cB + (size_t)(t + 2) * kstep;
            const char* a3 = a2 + kstep; const char* b3 = b2 + kstep;
            PG8_LDB(B0, 0, 0); PG8_SCHED; PG8_LDA(At, 0, 0); PG8_STAGE(PG8_SA(1, 1), a1 + hstep, voffA);
            PG8_WAIT_L(8); PG8_BAR; PG8_WAIT_L(0); PG8_MMA(0, 0, At, B0); PG8_BAR; PG8_SCHED;
            PG8_LDB(B1, 0, 1); PG8_STAGE(PG8_SB(0, 0), b2, voffB);
            PG8_BAR; PG8_WAIT_L(0); PG8_MMA(0, 1, At, B1); PG8_BAR;
            PG8_LDA(At, 0, 1); PG8_STAGE(PG8_SA(0, 0), a2, voffA);
            PG8_BAR; PG8_WAIT_L(0); PG8_MMA(1, 0, At, B0); PG8_BAR; PG8_SCHED;
            PG8_STAGE(PG8_SB(0, 1), b2 + hstep, voffB);
            PG8_WAIT_V(6); PG8_BAR; PG8_MMA(1, 1, At, B1); PG8_BAR;
            PG8_LDB(B0, 1, 0); PG8_SCHED; PG8_LDA(At, 1, 0); PG8_STAGE(PG8_SA(0, 1), a2 + hstep, voffA);
            PG8_WAIT_L(8); PG8_BAR; PG8_WAIT_L(0); PG8_MMA(0, 0, At, B0); PG8_BAR; PG8_SCHED;
            PG8_LDB(B1, 1, 1); PG8_STAGE(PG8_SB(1, 0), b3, voffB);
            PG8_BAR; PG8_WAIT_L(0); PG8_MMA(0, 1, At, B1); PG8_BAR;
            PG8_LDA(At, 1, 1); PG8_STAGE(PG8_SA(1, 0), a3, voffA);
            PG8_BAR; PG8_WAIT_L(0); PG8_MMA(1, 0, At, B0); PG8_BAR; PG8_SCHED;
            PG8_STAGE(PG8_SB(1, 1), b3 + hstep, voffB);
            PG8_WAIT_V(6); PG8_BAR; PG8_MMA(1, 1, At, B1); PG8_BAR;
        }
        E(acc, cur, wr, wc, fr, fq);
        if (!has_next) break;
#pragma unroll
        for (int a = 0; a < 2; ++a)
#pragma unroll
            for (int b = 0; b < 2; ++b)
#pragma unroll
                for (int m = 0; m < 4; ++m)
#pragma unroll
                    for (int n = 0; n < 2; ++n) acc[a][b][m][n] = (f32x4){0.f, 0.f, 0.f, 0.f};
        cur = nxt; cA = nA; cB = nB; ++ui;
    }
    PG8_WAIT_V(0);
    if (wr == 0) PG8_BAR;
    PG8_BAR;
#undef PG8_SA
#undef PG8_SB
#undef PG8_STAGE
#undef PG8_LDA
#undef PG8_LDB
#undef PG8_MMA
#undef PG8_WAIT_V
#undef PG8_WAIT_L
#undef PG8_BAR
#undef PG8_SCHED
}
struct EpiStore {
    static constexpr bool PERM = true;
    bf16_t* O; int ldc; int ncols; size_t split_stride;
    __device__ __forceinline__ void operator()(const f32x4 (&acc)[2][2][4][2], const Unit& u, int wr, int wc, int fr, int fq) const {
        const int row0 = u.pm * BM + wr * 64 + fr, col0 = u.pn * BM + wc * 32 + 8 * fq;
#pragma unroll
        for (int ai = 0; ai < 2; ++ai)
#pragma unroll
            for (int m = 0; m < 4; ++m) { bf16_t* rowp = O + (size_t)u.sp * split_stride + (size_t)(row0 + ai * HALF + m * 16) * ldc;
#pragma unroll
                for (int bj = 0; bj < 2; ++bj) { const int col = col0 + bj * HALF; if (col < ncols) {
                    const f32x4 v0 = acc[ai][bj][m][0], v1 = acc[ai][bj][m][1];
                    u32x4 o; o[0] = pk2(v0[0], v0[1]); o[1] = pk2(v0[2], v0[3]); o[2] = pk2(v1[0], v1[1]); o[3] = pk2(v1[2], v1[3]);
                    *(u32x4*)(rowp + col) = o; } } }
    }
};
struct EpiSwiglu {
    static constexpr bool PERM = true;
    bf16_t* O;
    __device__ __forceinline__ void operator()(const f32x4 (&acc)[2][2][4][2], const Unit& u, int wr, int wc, int fr, int fq) const {
        const int row0 = u.pm * BM + wr * 64 + fr, col0 = u.pn * 128 + wc * 32 + 8 * fq;
#pragma unroll
        for (int ai = 0; ai < 2; ++ai)
#pragma unroll
            for (int m = 0; m < 4; ++m) { bf16_t* rowp = O + (size_t)(row0 + ai * HALF + m * 16) * 2816 + col0;
                float r[8];
#pragma unroll
                for (int n = 0; n < 2; ++n)
#pragma unroll
                    for (int q = 0; q < 4; ++q) r[n * 4 + q] = silu_f(acc[ai][0][m][n][q]) * acc[ai][1][m][n][q];
                u32x4 o; o[0] = pk2(r[0], r[1]); o[1] = pk2(r[2], r[3]); o[2] = pk2(r[4], r[5]); o[3] = pk2(r[6], r[7]);
                *(u32x4*)rowp = o; }
    }
};
}

struct Job { const float* src; int ld, Ks, mode; bf16_t* dst; int Nd, Kd; };
__device__ __forceinline__ int job_srccol(int mode, int n0) {
    switch (mode) {
        case 0: return n0;
        case 1: return n0 < 1536 ? n0 : n0 + 32;
        case 2: return 1536;
        case 3: return n0 < 1984 ? n0 : -1;
        case 4: return (n0 >> 7) * 256 + (n0 & 127);
        case 5: return (n0 >> 7) * 256 + 128 + (n0 & 127);
        default: { const int pn = n0 >> 8, x0 = n0 & 255; return x0 < 128 ? pn * 128 + x0 : 2816 + pn * 128 + x0 - 128; }
    }
}
__device__ __forceinline__ Job get_job(PRef p, int idx) {
    Job j; unsigned char* ws = p.ws;
    if (idx < 2)       { const int i = idx;      j = {p.in[12] + (size_t)i * 1024 * 2592, 2592, 1024, 1, (bf16_t*)(ws + WS_WINE) + (size_t)i * 2560 * 1024, 2560, 1024}; }
    else if (idx < 4)  { const int i = idx - 2;  j = {p.in[12] + (size_t)i * 1024 * 2592, 2592, 1024, 2, (bf16_t*)(ws + WS_WZ) + (size_t)i * 32 * 1024, 32, 1024}; }
    else if (idx < 6)  { const int i = idx - 4;  j = {p.in[20] + (size_t)i * 1024 * 1024, 1024, 1024, 0, (bf16_t*)(ws + WS_WOUTE) + (size_t)i * 1024 * 1024, 1024, 1024}; }
    else if (idx < 8)  { const int i = idx - 6;  j = {p.in[21] + (size_t)i * 1024 * 1984, 1984, 1024, 3, (bf16_t*)(ws + WS_WINO) + (size_t)i * 2048 * 1024, 2048, 1024}; }
    else if (idx < 10) { const int i = idx - 8;  j = {p.in[35] + (size_t)i * 1024 * 1024, 1024, 1024, 0, (bf16_t*)(ws + WS_WOUTO) + (size_t)i * 1024 * 1024, 1024, 1024}; }
    else if (idx < 12) { const int i = idx - 10; j = {p.in[32] + (size_t)i * 256 * 768, 768, 256, 0, (bf16_t*)(ws + WS_WQB) + (size_t)i * 768 * 256, 768, 256}; }
    else if (idx < 14) { const int i = idx - 12; j = {p.in[34] + (size_t)i * 128 * 1024, 1024, 128, 4, (bf16_t*)(ws + WS_WKVK) + (size_t)i * 512 * 256, 512, 256}; }
    else if (idx < 16) { const int i = idx - 14; j = {p.in[34] + (size_t)i * 128 * 1024, 1024, 128, 5, (bf16_t*)(ws + WS_WKVV) + (size_t)i * 512 * 256, 512, 256}; }
    else if (idx < 20) { const int i = idx - 16; j = {p.in[36] + (size_t)i * 1024 * 5632, 5632, 1024, 6, (bf16_t*)(ws + WS_WFI) + (size_t)i * 5632 * 1024, 5632, 1024}; }
    else               { const int i = idx - 20; j = {p.in[37] + (size_t)i * 2816 * 1024, 1024, 2816, 0, (bf16_t*)(ws + WS_WFO) + (size_t)i * 1024 * 2816, 1024, 2816}; }
    return j;
}
constexpr int N_JOBS = 24;

__device__ __forceinline__ void conv_tile(const Job& jb, int tile, float* tl) {
    const int nkt = jb.Kd >> 8; const int nti = tile / nkt, kt = tile % nkt; const int n0 = nti * 64, k0 = kt * 256;
    const int sc = job_srccol(jb.mode, n0);
    const int t = tidx();
    if (sc >= 0) {
        f32x4 v[8];
#pragma unroll
        for (int q = 0; q < 8; ++q) { const int idx = t + 512 * q, k = idx >> 4, c4 = idx & 15;
            v[q] = (k0 + k < jb.Ks) ? *(const f32x4*)(jb.src + (size_t)(k0 + k) * jb.ld + sc + c4 * 4) : (f32x4){0.f, 0.f, 0.f, 0.f}; }
#pragma unroll
        for (int q = 0; q < 8; ++q) { const int idx = t + 512 * q, k = idx >> 4, c4 = idx & 15; float* d = tl + k * 65 + c4 * 4; d[0] = v[q][0]; d[1] = v[q][1]; d[2] = v[q][2]; d[3] = v[q][3]; } }
    __syncthreads();
    { const int kq = t & 7, n = t >> 3;
      if (n0 + n < jb.Nd) {
#pragma unroll
          for (int m = 0; m < 4; ++m) { const int kc = kq + 8 * m; float v[8];
#pragma unroll
              for (int i = 0; i < 8; ++i) v[i] = sc < 0 ? 0.f : tl[(kc * 8 + i) * 65 + n];
              u32x4 o; o[0] = pk2(v[0], v[1]); o[1] = pk2(v[2], v[3]); o[2] = pk2(v[4], v[5]); o[3] = pk2(v[6], v[7]);
              *(u32x4*)(jb.dst + (size_t)(n0 + n) * jb.Kd + k0 + kc * 8) = o; } } }
    __syncthreads();
}

__device__ __forceinline__ int layer_job(int l, int k) {
    const int j = l >> 1;
    if ((l & 1) == 0) { switch (k) { case 0: return j; case 1: return 2 + j; case 2: return 4 + j; case 3: return 16 + l; case 4: return 20 + l; default: return -1; } }
    switch (k) { case 0: return 6 + j; case 1: return 8 + j; case 2: return 10 + j; case 3: return 12 + j; case 4: return 14 + j; case 5: return 16 + l; case 6: return 20 + l; default: return -1; }
}
__device__ __forceinline__ void conv_layer(PRef p, int l, int wi, int nw, float* tl, int which = 0  ) {
    int tbase = 0;
    for (int k = 0; k < 7; ++k) { const int ji = layer_job(l, k); if (ji < 0) break;
        const bool is_fo = ji >= 20; if ((which == 1 && is_fo) || (which == 2 && !is_fo)) continue;
        const Job jb = get_job(p, ji); const int ntile = ((jb.Nd + 63) >> 6) * (jb.Kd >> 8);
        const int first = (wi - (tbase % nw) + nw) % nw;
        for (int tile = first; tile < ntile; tile += nw) conv_tile(jb, tile, tl);
        tbase += ntile; }
}

__device__ __forceinline__ void phase_prep(PRef p, unsigned char* shm) {
    const int t = tidx(), wg = bidx(), nwg = gdim();
    unsigned char* ws = p.ws;
    { float* X = (float*)(ws + WS_X); const f32x4* xp = (const f32x4*)p.in[0]; const f32x4* xs = (const f32x4*)p.in[1]; f32x4* X4 = (f32x4*)X;
      const size_t n4 = (size_t)T * 256, np4 = (size_t)4096 * 256;
      for (size_t i = (size_t)wg * 512 + t; i < n4; i += (size_t)nwg * 512) X4[i] = i < np4 ? xp[i] : xs[i - np4];
      bf16_t* CKV = (bf16_t*)(ws + WS_CKV); bf16_t* KPE = (bf16_t*)(ws + WS_KPE);
      for (size_t i = (size_t)wg * 512 + t; i < (size_t)2 * TK * 256; i += (size_t)nwg * 512) {
          const int j = (int)(i / ((size_t)TK * 256)); const int rem = (int)(i % ((size_t)TK * 256)); const int r = rem >> 8, c = rem & 255;
          if (c >= 128) CKV[i] = 0;
          else if (r >= T) { const int b = (r - T) >> 9, pp = (r - T) & 511; CKV[i] = f2bf(p.in[6][((size_t)(b * 2 + j) * 512 + pp) * 128 + c]); } }
      for (size_t i = (size_t)wg * 512 + t; i < (size_t)2 * 1024 * 64; i += (size_t)nwg * 512) {
          const int j = (int)(i >> 16); const int rem = (int)(i & 65535); const int rr = rem >> 6, c = rem & 63; const int b = rr >> 9, pp = rr & 511;
          KPE[((size_t)j * TK + T + rr) * 64 + c] = f2bf(p.in[7][((size_t)(b * 2 + j) * 512 + pp) * 64 + c]); } }
    float* sc = (float*)(shm + 81920);
    float* red = sc + 3072;
    {
      for (int i = t; i < 3072; i += 512) { const int ci = i >> 10, k = i & 1023; const float v = ci == 0 ? p.in[9][k] : p.in[8][(ci - 1) * 1024 + k]; sc[i] = silu_f(v); }
      __syncthreads();
      }
    auto adaln_task = [&](int task) {
          float* MOD = (float*)(ws + WS_MOD);
          const int l = task / 96, cb = task % 96; const int col = t & 63, kg = t >> 6;
          const float* w = p.in[10] + (size_t)l * 1024 * 6144 + cb * 64 + col;
          float a0 = 0.f, a1 = 0.f, a2 = 0.f;
#pragma unroll 8
          for (int k = kg * 128; k < kg * 128 + 128; ++k) { const float wv = w[(size_t)k * 6144]; a0 += sc[k] * wv; a1 += sc[1024 + k] * wv; a2 += sc[2048 + k] * wv; }
          red[(kg * 3 + 0) * 64 + col] = a0; red[(kg * 3 + 1) * 64 + col] = a1; red[(kg * 3 + 2) * 64 + col] = a2;
          __syncthreads();
          if (t < 192) { const int ci = t >> 6, c2 = t & 63; float s = p.in[11][(size_t)l * 6144 + cb * 64 + c2];
#pragma unroll
              for (int g = 0; g < 8; ++g) s += red[(g * 3 + ci) * 64 + c2];
              MOD[((size_t)l * 3 + ci) * 6144 + cb * 64 + c2] = s; }
          __syncthreads();
      };
    float* zf = (float*)shm;
    float* h1 = zf + 320;
    float* h2 = h1 + 512;
    bf16_t* GR = (bf16_t*)(ws + WS_GR);
    auto filter_task = [&](int task) {
          const int j = task / 160, tb = task % 160; const int type = tb < 32 ? 0 : 1; const int L = type ? 1024 : 256; const int pos0 = (type ? tb - 32 : tb) * 8;
          if (t < 8 * 33) { const int pi = t / 33, e = t % 33; const int idx = pos0 + pi; float v;
              if (e == 0) v = (float)idx / (float)(L - 1);
              else { const int b = (e - 1) & 15; const float f = 1e-4f + (float)b * ((15.0f - 1e-4f) / 15.0f); const float w = 6.283185307179586f * (float)idx / (float)L; v = e <= 16 ? __cosf(f * w) : -__sinf(f * w); }
              zf[pi * 40 + e] = v; }
          __syncthreads();
          { const int pi = t >> 6, u = t & 63; float s = p.in[26][j * 64 + u]; const float* w1 = p.in[25] + (size_t)j * 33 * 64 + u;
            for (int e = 0; e < 33; ++e) s += zf[pi * 40 + e] * w1[e * 64];
            h1[pi * 64 + u] = __sinf(p.in[27][j * 64 + u] * s); }
          __syncthreads();
          { const int pi = t >> 6, u = t & 63; float s = p.in[29][j * 64 + u]; const float* w2 = p.in[28] + (size_t)j * 64 * 64 + u;
            for (int e = 0; e < 64; ++e) s += h1[pi * 64 + e] * w2[e * 64];
            h2[pi * 64 + u] = __sinf(p.in[27][j * 64 + u] * s); }
          __syncthreads();
          { const float* w3 = p.in[30] + (size_t)j * 64 * 1024;
            bf16_t* gr = GR + (size_t)j * 512 * 2560 + (type ? (size_t)512 * 512 : 0);
            for (int cc = 0; cc < 2; ++cc) { const int col = t + cc * 512; float a[8];
#pragma unroll
                for (int q = 0; q < 8; ++q) a[q] = 0.f;
                for (int e = 0; e < 64; ++e) { const float wv = w3[e * 1024 + col];
#pragma unroll
                    for (int q = 0; q < 8; ++q) a[q] += h2[q * 64 + e] * wv; }
                const int ch = col & 511; const float delta = fabsf(-3.0701134573253945f + (float)ch * ((-15.350567286626973f + 3.0701134573253945f) / 511.0f));
                bf16_t* grc = gr + (size_t)ch * (2 * L);
#pragma unroll
                for (int q = 0; q < 8; ++q) { const int idx = pos0 + q; const float tp = (float)idx / (float)(L - 1); const float v = a[q] * __expf(-tp * delta);
                    if (col < 512) grc[L - 1 - idx] = f2bf(v);
                    else if (idx >= 1) grc[L - 1 + idx] = f2bf(v);
                    else grc[2 * L - 1] = 0; } } }
          __syncthreads();
      };
    { int jstart[8]; int total = 0;
#pragma unroll
      for (int k = 0; k < 7; ++k) { const int ji = layer_job(0, k); jstart[k] = total; if (ji >= 0) { const Job jb = get_job(p, ji); total += ((jb.Nd + 63) >> 6) * (jb.Kd >> 8); } }
      unsigned* q = (unsigned*)(ws + WS_BAR) + 15; volatile unsigned* slot = (volatile unsigned*)(shm + (LDS_BYTES - 32));
      for (;;) {
          if (threadIdx.x == 0) *slot = __hip_atomic_fetch_add(q, 1u, __ATOMIC_RELAXED, __HIP_MEMORY_SCOPE_AGENT);
          __syncthreads();
          const int it = (int)*slot;
          __syncthreads();
          if (it >= 704 + total) break;
          if (it < 320) filter_task(it);
          else if (it < 704) adaln_task(it - 320);
          else { const int idx = it - 704; int k = 0, base = 0;
#pragma unroll
              for (int z = 1; z < 7; ++z) if (idx >= jstart[z]) { k = z; base = jstart[z]; }
              const Job jb = get_job(p, layer_job(0, k)); conv_tile(jb, idx - base, (float*)shm); }
      } }
}

__device__ __forceinline__ void phase_norm(PRef p, int l, int which  ) {
    const int lane = tidx() & 63, wv = tidx() >> 6;
    float* X = (float*)(p.ws + WS_X); bf16_t* H = (bf16_t*)(p.ws + WS_H); const float* MOD = (const float*)(p.ws + WS_MOD); const bf16_t* P = (const bf16_t*)(p.ws + WS_P);
    const bool add = !(which == 0 && l == 0);
    const int gl = which == 1 ? l : (which == 2 ? 3 : l - 1); const int goff = which == 1 ? 2048 : 5120;
    const int stride = gdim() * 8;
    for (int rowb = bidx() * 8 + wv; rowb < T; rowb += 2 * stride) {
        f32x4 v[2][4]; float rstd[2];
#pragma unroll
        for (int u = 0; u < 2; ++u) { const int row = rowb + u * stride; if (row < T) {
            if (!add) { const f32x4* xi = (const f32x4*)(row < 4096 ? p.in[0] + (size_t)row * 1024 : p.in[1] + (size_t)(row - 4096) * 1024);
#pragma unroll
                for (int i = 0; i < 4; ++i) v[u][i] = xi[lane + 64 * i]; }
            else { const f32x4* xr = (const f32x4*)(X + (size_t)row * 1024);
#pragma unroll
                for (int i = 0; i < 4; ++i) v[u][i] = xr[lane + 64 * i]; } } }
        if (add) {
            f32x4 g[2][4]; u32x2 pa[2][4], pb[2][4];
#pragma unroll
            for (int u = 0; u < 2; ++u) { const int row = rowb + u * stride; if (row < T) { const float* gp = MOD + ((size_t)gl * 3 + cvec_of(row)) * 6144 + goff;
#pragma unroll
                for (int i = 0; i < 4; ++i) { g[u][i] = ((const f32x4*)gp)[lane + 64 * i];
                    pa[u][i] = *(const u32x2*)(P + (size_t)row * 1024 + (lane + 64 * i) * 4); pb[u][i] = *(const u32x2*)(P + (size_t)T * 1024 + (size_t)row * 1024 + (lane + 64 * i) * 4); } } }
#pragma unroll
            for (int u = 0; u < 2; ++u) { const int row = rowb + u * stride; if (row < T) {
#pragma unroll
                for (int i = 0; i < 4; ++i) { const u32x2 a = pa[u][i], b = pb[u][i]; f32x4 s4;
                    s4[0] = __uint_as_float(a[0] << 16) + __uint_as_float(b[0] << 16); s4[1] = __uint_as_float(a[0] & 0xFFFF0000u) + __uint_as_float(b[0] & 0xFFFF0000u);
                    s4[2] = __uint_as_float(a[1] << 16) + __uint_as_float(b[1] << 16); s4[3] = __uint_as_float(a[1] & 0xFFFF0000u) + __uint_as_float(b[1] & 0xFFFF0000u);
                    v[u][i] += g[u][i] * s4; } } }
        }
        f32x4 sh[2][4], sc[2][4];
#pragma unroll
        for (int u = 0; u < 2; ++u) { const int row = rowb + u * stride; if (row < T) {
            if (which == 2) {
#pragma unroll
                for (int i = 0; i < 4; ++i) sc[u][i] = ((const f32x4*)p.in[38])[lane + 64 * i]; }
            else { const float* m = MOD + ((size_t)l * 3 + cvec_of(row)) * 6144 + which * 3072;
#pragma unroll
                for (int i = 0; i < 4; ++i) { sh[u][i] = ((const f32x4*)m)[lane + 64 * i]; sc[u][i] = ((const f32x4*)(m + 1024))[lane + 64 * i]; } } } }
#pragma unroll
        for (int u = 0; u < 2; ++u) { const int row = rowb + u * stride; if (row < T) { float ss = 0.f;
#pragma unroll
            for (int i = 0; i < 4; ++i) ss += v[u][i][0] * v[u][i][0] + v[u][i][1] * v[u][i][1] + v[u][i][2] * v[u][i][2] + v[u][i][3] * v[u][i][3];
            ss = wave_sum(ss); rstd[u] = rsqrtf(ss * (1.0f / 1024.0f) + EPS); } }
#pragma unroll
        for (int u = 0; u < 2; ++u) { const int row = rowb + u * stride; if (row < T) {
            if (which != 2 || true) { if (which != 2) { f32x4* xr = (f32x4*)(X + (size_t)row * 1024);
#pragma unroll
                for (int i = 0; i < 4; ++i) xr[lane + 64 * i] = v[u][i]; } }
            if (which == 2) { float* o = p.out + (row < 4096 ? O_YP + (size_t)row * 1024 : O_YS + (size_t)(row - 4096) * 1024);
#pragma unroll
                for (int i = 0; i < 4; ++i) ((f32x4*)o)[lane + 64 * i] = v[u][i] * rstd[u] * sc[u][i]; }
            else {
#pragma unroll
                for (int i = 0; i < 4; ++i) { const f32x4 hv = v[u][i] * rstd[u] * (sc[u][i] + 1.0f) + sh[u][i]; u32x2 o; o[0] = pk2(hv[0], hv[1]); o[1] = pk2(hv[2], hv[3]);
                    *(u32x2*)(H + (size_t)row * 1024 + (lane + 64 * i) * 4) = o; } } } }
    }
}

__device__ __forceinline__ void phase_zgemm(PRef p, int j, unsigned char* shm) {
    const int t = tidx(), lane = t & 63, wv = t >> 6, r = lane & 31, h = lane >> 5;
    const bf16_t* H = (const bf16_t*)(p.ws + WS_H); const bf16_t* WZ = (const bf16_t*)(p.ws + WS_WZ) + (size_t)j * 32 * 1024; float* ZG = (float*)(p.ws + WS_ZG);
    float* red = (float*)shm;
    for (int tile = bidx(); tile < T / 32; tile += gdim()) {
        f32x16 acc = zero16();
        const bf16_t* a = H + (size_t)(tile * 32 + r) * 1024 + wv * 128 + 8 * h; const bf16_t* b = WZ + (size_t)r * 1024 + wv * 128 + 8 * h;
        bf16x8 av[8], bv[8];
#pragma unroll
        for (int ks = 0; ks < 8; ++ks) { av[ks] = *(const bf16x8*)(a + ks * 16); bv[ks] = *(const bf16x8*)(b + ks * 16); }
#pragma unroll
        for (int ks = 0; ks < 8; ++ks) acc = mfma32(av[ks], bv[ks], acc);
#pragma unroll
        for (int q = 0; q < 16; ++q) red[(wv * 16 + q) * 64 + lane] = acc[q];
        __syncthreads();
        for (int e = t; e < 1024; e += 512) { const int q = e >> 6, ln = e & 63; float s2 = 0.f;
#pragma unroll
            for (int w = 0; w < 8; ++w) s2 += red[(w * 16 + q) * 64 + ln];
            const int row = tile * 32 + (q & 3) + 8 * (q >> 2) + 4 * (ln >> 5); ZG[(size_t)row * 32 + (ln & 31)] = s2; }
        __syncthreads();
    }
}

__device__ __forceinline__ int seq_base(int s) { return s < 16 ? s * 256 : 4096 + (s - 16) * 1024; }
__device__ __forceinline__ int gla_item(int s, int h, int c, int dir) { return s < 16 ? ((s * 4 + h) * 4 + c) * 2 + dir : 512 + (((s - 16) * 4 + h) * 16 + c) * 2 + dir; }
constexpr int GLD = 72;

__device__ __forceinline__ void gla_gates(PRef p, int j, int h, int dir, int tok0, float* ZL, float* PT, float (&b)[8], float& blast) {
    const int t = tidx(), d = t & 63, g8 = t >> 6;
    const float* ZG = (const float*)(p.ws + WS_ZG);
    for (int e = t; e < 1024; e += 512) { const int ip = e >> 4, jz = e & 15; const int tok = tok0 + (dir ? 63 - ip : ip); ZL[e] = ZG[(size_t)tok * 32 + dir * 16 + jz]; }
    __syncthreads();
    const float* wg_ = p.in[dir ? 15 : 13] + (size_t)j * 16 * 256 + h * 64 + d;
    float w[16];
#pragma unroll
    for (int q = 0; q < 16; ++q) w[q] = wg_[q * 256];
    const float bias = p.in[dir ? 16 : 14][j * 256 + h * 64 + d];
    float run = 0.f;
#pragma unroll
    for (int ii = 0; ii < 8; ++ii) { const int ip = g8 * 8 + ii; float x = bias;
#pragma unroll
        for (int q = 0; q < 16; ++q) x += ZL[ip * 16 + q] * w[q];
        const float ls = fminf(x, 0.f) - log1pf(__expf(-fabsf(x)));
        run += ls * (1.0f / 16.0f); b[ii] = run; }
    PT[g8 * 64 + d] = run;
    __syncthreads();
    float off = 0.f, tot = 0.f;
#pragma unroll
    for (int g = 0; g < 8; ++g) { const float v = PT[g * 64 + d]; tot += v; if (g < g8) off += v; }
#pragma unroll
    for (int ii = 0; ii < 8; ++ii) b[ii] += off;
    blast = tot;
    __syncthreads();
}
__device__ __forceinline__ void gla_load_vt(const bf16_t* PROJ, int h, int dir, int tok0, bf16_t* VTL) {
    const int t = tidx(), e = t & 127, grp = t >> 7;
    unsigned pk[8];
#pragma unroll
    for (int q = 0; q < 8; ++q) { const int i0 = grp * 16 + 2 * q; const int tk0 = tok0 + (dir ? 63 - i0 : i0), tk1 = tok0 + (dir ? 62 - i0 : i0 + 1);
        const unsigned lo = PROJ[(size_t)tk0 * 2560 + 512 + h * 128 + e], hi = PROJ[(size_t)tk1 * 2560 + 512 + h * 128 + e]; pk[q] = lo | (hi << 16); }
    u32x4 o0, o1; o0[0] = pk[0]; o0[1] = pk[1]; o0[2] = pk[2]; o0[3] = pk[3]; o1[0] = pk[4]; o1[1] = pk[5]; o1[2] = pk[6]; o1[3] = pk[7];
    *(u32x4*)(VTL + e * GLD + grp * 16) = o0; *(u32x4*)(VTL + e * GLD + grp * 16 + 8) = o1;
}

__device__ __forceinline__ void gla_pass_a(PRef p, int j, int item, unsigned char* shm) {
    int s, h, c, dir;
    if (item < 512) { s = item >> 5; const int rem = item & 31; h = rem >> 3; c = (rem & 7) >> 1; dir = rem & 1; }
    else { const int it = item - 512; s = 16 + (it >> 7); const int rem = it & 127; h = rem >> 5; c = (rem & 31) >> 1; dir = rem & 1; }
    const int tok0 = seq_base(s) + 64 * c;
    bf16_t* KTL = (bf16_t*)shm;
    bf16_t* VTL = KTL + 64 * GLD;
    float* ZL = (float*)(VTL + 128 * GLD);
    float* PT = ZL + 1024;
    const bf16_t* PROJ = (const bf16_t*)(p.ws + WS_PROJ);
    float* DS = (float*)(p.ws + WS_DS) + (size_t)item * 8192; float* DEC = (float*)(p.ws + WS_DEC) + (size_t)item * 64;
    const int t = tidx(), d = t & 63, g8 = t >> 6;
    bf16_t kr[8];
#pragma unroll
    for (int ii = 0; ii < 8; ++ii) { const int ip = g8 * 8 + ii; const int tok = tok0 + (dir ? 63 - ip : ip); kr[ii] = PROJ[(size_t)tok * 2560 + 256 + h * 64 + d]; }
    gla_load_vt(PROJ, h, dir, tok0, VTL);
    float b[8], blast;
    gla_gates(p, j, h, dir, tok0, ZL, PT, b, blast);
    { unsigned pk[4];
#pragma unroll
      for (int q = 0; q < 4; ++q) pk[q] = pk2(bf2f(kr[2 * q]) * __expf(blast - b[2 * q]), bf2f(kr[2 * q + 1]) * __expf(blast - b[2 * q + 1]));
      u32x4 o; o[0] = pk[0]; o[1] = pk[1]; o[2] = pk[2]; o[3] = pk[3];
      *(u32x4*)(KTL + d * GLD + g8 * 8) = o; }
    if (t < 64) DEC[t] = __expf(blast);
    __syncthreads();
    { const int wv = t >> 6, lane = t & 63, mt = wv >> 2, nt = wv & 3, hh = lane >> 5, r = lane & 31;
      f32x16 acc = mma_rows(KTL + mt * 32 * GLD, GLD, VTL + nt * 32 * GLD, GLD, 64, zero16());
#pragma unroll
      for (int q = 0; q < 16; ++q) { const int dd = 32 * mt + (q & 3) + 8 * (q >> 2) + 4 * hh; DS[dd * 128 + 32 * nt + r] = acc[q]; } }
    __syncthreads();
}

__device__ __forceinline__ void gla_pass_b(PRef p, int j, int item, unsigned char* shm) {
    int s, h, c, nC;
    if (item < 256) { s = item >> 4; h = (item >> 2) & 3; c = item & 3; nC = 4; }
    else { const int it = item - 256; s = 16 + (it >> 6); h = (it >> 4) & 3; c = it & 15; nC = 16; }
    const int tok0 = seq_base(s) + 64 * c;
    float* OL = (float*)shm;
    bf16_t* QL = (bf16_t*)(OL + 64 * 132);
    bf16_t* KL = QL + 64 * GLD;
    bf16_t* PL = KL + 64 * GLD;
    bf16_t* VTL = PL + 64 * GLD;
    bf16_t* STL = VTL + 128 * GLD;
    float* ZL = (float*)(STL + 128 * GLD);
    float* PT = ZL + 1024;
    const bf16_t* PROJ = (const bf16_t*)(p.ws + WS_PROJ);
    const float* DSb = (const float*)(p.ws + WS_DS); const float* DECb = (const float*)(p.ws + WS_DEC);
    const int t = tidx(), d = t & 63, g8 = t >> 6, wv = t >> 6, lane = t & 63;
    bf16_t ra0[8], ra1[8];
#pragma unroll
    for (int q = 0; q < 8; ++q) { const int tok = tok0 + wv * 8 + q; ra0[q] = PROJ[(size_t)tok * 2560 + 1024 + h * 128 + lane]; ra1[q] = PROJ[(size_t)tok * 2560 + 1024 + h * 128 + 64 + lane]; }
    for (int dir = 0; dir < 2; ++dir) {
        bf16_t qr[8], kr[8];
#pragma unroll
        for (int ii = 0; ii < 8; ++ii) { const int ip = g8 * 8 + ii; const int tok = tok0 + (dir ? 63 - ip : ip);
            qr[ii] = PROJ[(size_t)tok * 2560 + h * 64 + d]; kr[ii] = PROJ[(size_t)tok * 2560 + 256 + h * 64 + d]; }
        gla_load_vt(PROJ, h, dir, tok0, VTL);
        { const int e = t & 127, dg = t >> 7; float S[16];
          if (s >= 16) { const float* st = p.in[dir ? 3 : 2] + ((size_t)((s - 16) * 2 + j) * 4 + h) * 8192;
#pragma unroll
              for (int i = 0; i < 16; ++i) S[i] = st[(dg * 16 + i) * 128 + e]; }
          else {
#pragma unroll
              for (int i = 0; i < 16; ++i) S[i] = 0.f; }
          const int nprev = dir ? nC - 1 - c : c;
#pragma unroll 2
          for (int q = 0; q < nprev; ++q) { const int cc = dir ? nC - 1 - q : q; const int it = gla_item(s, h, cc, dir);
              const float* ds = DSb + (size_t)it * 8192 + (size_t)(dg * 16) * 128 + e; const f32x4* dc4 = (const f32x4*)(DECb + (size_t)it * 64 + dg * 16);
              float dv[16]; f32x4 dcv[4];
#pragma unroll
              for (int i = 0; i < 4; ++i) dcv[i] = dc4[i];
#pragma unroll
              for (int i = 0; i < 16; ++i) dv[i] = ds[i * 128];
#pragma unroll
              for (int i = 0; i < 16; ++i) S[i] = S[i] * dcv[i >> 2][i & 3] + dv[i]; }
          u32x4 o0, o1;
          o0[0] = pk2(S[0], S[1]); o0[1] = pk2(S[2], S[3]); o0[2] = pk2(S[4], S[5]); o0[3] = pk2(S[6], S[7]);
          o1[0] = pk2(S[8], S[9]); o1[1] = pk2(S[10], S[11]); o1[2] = pk2(S[12], S[13]); o1[3] = pk2(S[14], S[15]);
          *(u32x4*)(STL + e * GLD + dg * 16) = o0; *(u32x4*)(STL + e * GLD + dg * 16 + 8) = o1;
          if (s < 16 && ((dir == 0 && c == nC - 1) || (dir == 1 && c == 0))) {
              const int it = gla_item(s, h, c, dir); const float* ds = DSb + (size_t)it * 8192; const float* dc = DECb + (size_t)it * 64;
              float* o = p.out + (dir ? O_SB : O_SF) + ((size_t)(s * 2 + j) * 4 + h) * 8192;
#pragma unroll
              for (int i = 0; i < 16; ++i) o[(dg * 16 + i) * 128 + e] = S[i] * dc[dg * 16 + i] + ds[(dg * 16 + i) * 128 + e]; } }
        float b[8], blast;
        gla_gates(p, j, h, dir, tok0, ZL, PT, b, blast);
#pragma unroll
        for (int ii = 0; ii < 8; ++ii) { const int ip = g8 * 8 + ii;
            const float qv = bf2f(qr[ii]) * 0.125f * __expf(b[ii]);
            const float kv = bf2f(kr[ii]) * __expf(-b[ii]);
            QL[ip * GLD + d] = f2bf(qv); KL[ip * GLD + d] = f2bf(kv); }
        __syncthreads();
        const int hh = lane >> 5, r = lane & 31;
        if (wv < 4) { const int mt = wv >> 1, nt = wv & 1;
            f32x16 sc = mma_rows(QL + mt * 32 * GLD, GLD, KL + nt * 32 * GLD, GLD, 64, zero16());
#pragma unroll
            for (int q = 0; q < 16; ++q) { const int ip = 32 * mt + (q & 3) + 8 * (q >> 2) + 4 * hh, jp = 32 * nt + r; PL[ip * GLD + jp] = f2bf(jp <= ip ? sc[q] : 0.f); } }
        const int mt = wv >> 2, nt = wv & 3;
        f32x16 acc = mma_rows(QL + mt * 32 * GLD, GLD, STL + nt * 32 * GLD, GLD, 64, zero16());
        __syncthreads();
        acc = mma_rows(PL + mt * 32 * GLD, GLD, VTL + nt * 32 * GLD, GLD, 64, acc);
#pragma unroll
        for (int q = 0; q < 16; ++q) { const int ip = 32 * mt + (q & 3) + 8 * (q >> 2) + 4 * hh; const int pp = dir ? 63 - ip : ip; float* o = OL + pp * 132 + 32 * nt + r;
            if (dir == 0) *o = acc[q]; else *o += acc[q]; }
        __syncthreads();
    }
    bf16_t* MIX = (bf16_t*)(p.ws + WS_MIX);
    const float g0 = p.in[17][j * 128 + lane], g1 = p.in[17][j * 128 + 64 + lane];
#pragma unroll
    for (int q = 0; q < 8; ++q) { const int pp = wv * 8 + q; const int tok = tok0 + pp;
        const float v0 = OL[pp * 132 + lane], v1 = OL[pp * 132 + 64 + lane];
        const float ss = wave_sum(v0 * v0 + v1 * v1); const float rstd = rsqrtf(ss * (1.0f / 128.0f) + EPS);
        const float r0 = bf2f(ra0[q]), r1 = bf2f(ra1[q]);
        MIX[(size_t)tok * 1024 + h * 128 + lane] = f2bf(v0 * rstd * g0 * silu_f(r0));
        MIX[(size_t)tok * 1024 + h * 128 + 64 + lane] = f2bf(v1 * rstd * g1 * silu_f(r1)); }
    __syncthreads();
}

__device__ __forceinline__ void gqa_prep(PRef p, int j, int rb, unsigned char* shm) {
    const int t = tidx(), lane = t & 63, wv = t >> 6;
    const int r0 = rb * 64;
    const bf16_t* PROJ = (const bf16_t*)(p.ws + WS_PROJ);
    bf16_t* QNG = (bf16_t*)(p.ws + WS_QNG); bf16_t* KNG = (bf16_t*)(p.ws + WS_KNG); bf16_t* VTG = (bf16_t*)(p.ws + WS_VTG);
    bf16_t* VL = (bf16_t*)shm;
    const bool ctx = r0 >= T;
    if (!ctx) {
        const float gq0 = p.in[18][j * 128 + lane], gq1 = p.in[18][j * 128 + 64 + lane], gk0 = p.in[19][j * 128 + lane], gk1 = p.in[19][j * 128 + 64 + lane];
        const float inv = exp2f(-(float)(lane & 31) * (13.287712379549449f / 32.0f));
        for (int hb = 0; hb < 6; ++hb) {
            bf16_t r1[8], r2[8];
#pragma unroll
            for (int u = 0; u < 8; ++u) { const int hv = wv * 48 + hb * 8 + u; const int row = r0 + hv / 6, which = hv % 6; const int col = which < 4 ? 1536 + which * 128 : 2048 + (which - 4) * 128;
                r1[u] = PROJ[(size_t)row * 2560 + col + lane]; r2[u] = PROJ[(size_t)row * 2560 + col + 64 + lane]; }
#pragma unroll
            for (int u = 0; u < 8; ++u) { const int hv = wv * 48 + hb * 8 + u; const int row = r0 + hv / 6, which = hv % 6;
                float x1 = bf2f(r1[u]), x2 = bf2f(r2[u]);
                const float ss = wave_sum(x1 * x1 + x2 * x2); const float rstd = rsqrtf(ss * (1.0f / 128.0f) + EPS);
                x1 = x1 * rstd * (which < 4 ? gq0 : gk0); x2 = x2 * rstd * (which < 4 ? gq1 : gk1);
                if (row < 4096) {
                    if (which >= 4) { const int b = row >> 8, tt = row & 255; float* o = p.out + O_CK + ((size_t)(b * 2 + j) * 256 + tt) * 256 + (which - 4) * 128; o[lane] = x1; o[64 + lane] = x2; }
                } else { const int tt = (row - 4096) & 1023; const float pos = lane < 32 ? (float)(tt >> 6) : (float)(tt & 63); const float ang = pos * inv;
                    const float cs = __cosf(ang), sn = __sinf(ang); const float y1 = x1 * cs - x2 * sn, y2 = x1 * sn + x2 * cs; x1 = y1; x2 = y2; }
                if (which < 4) { QNG[(size_t)row * 512 + which * 128 + lane] = f2bf(x1); QNG[(size_t)row * 512 + which * 128 + 64 + lane] = f2bf(x2); }
                else { KNG[(size_t)row * 256 + (which - 4) * 128 + lane] = f2bf(x1); KNG[(size_t)row * 256 + (which - 4) * 128 + 64 + lane] = f2bf(x2); } } }
        { u32x4 vv[4];
#pragma unroll
          for (int i = 0; i < 4; ++i) { const int c = t + 512 * i, rr = c >> 5, piece = c & 31; vv[i] = *(const u32x4*)(PROJ + (size_t)(r0 + rr) * 2560 + 2304 + piece * 8); }
#pragma unroll
          for (int i = 0; i < 4; ++i) { const int c = t + 512 * i, rr = c >> 5, piece = c & 31; const int row = r0 + rr;
              *(u32x4*)(VL + rr * 264 + piece * 8) = vv[i];
              if (row < 4096) { const int b = row >> 8, tt = row & 255; float* o = p.out + O_CV + ((size_t)(b * 2 + j) * 256 + tt) * 256 + piece * 8;
                  f32x4 o0, o1; o0[0] = __uint_as_float(vv[i][0] << 16); o0[1] = __uint_as_float(vv[i][0] & 0xFFFF0000u); o0[2] = __uint_as_float(vv[i][1] << 16); o0[3] = __uint_as_float(vv[i][1] & 0xFFFF0000u);
                  o1[0] = __uint_as_float(vv[i][2] << 16); o1[1] = __uint_as_float(vv[i][2] & 0xFFFF0000u); o1[2] = __uint_as_float(vv[i][3] << 16); o1[3] = __uint_as_float(vv[i][3] & 0xFFFF0000u);
                  *(f32x4*)o = o0; *(f32x4*)(o + 4) = o1; } } }
    } else {
        f32x4 kk[4][2], vv[4][2];
#pragma unroll
        for (int i = 0; i < 4; ++i) { const int c = t + 512 * i, rr = c >> 5, piece = c & 31; const int row = r0 + rr; const int b = (row - T) >> 9, pp = (row - T) & 511;
            const size_t ci = ((size_t)(b * 2 + j) * 512 + pp) * 256 + piece * 8;
            kk[i][0] = *(const f32x4*)(p.in[4] + ci); kk[i][1] = *(const f32x4*)(p.in[4] + ci + 4); vv[i][0] = *(const f32x4*)(p.in[5] + ci); vv[i][1] = *(const f32x4*)(p.in[5] + ci + 4); }
#pragma unroll
        for (int i = 0; i < 4; ++i) { const int c = t + 512 * i, rr = c >> 5, piece = c & 31; const int row = r0 + rr;
            u32x4 ko, vo; ko[0] = pk2(kk[i][0][0], kk[i][0][1]); ko[1] = pk2(kk[i][0][2], kk[i][0][3]); ko[2] = pk2(kk[i][1][0], kk[i][1][1]); ko[3] = pk2(kk[i][1][2], kk[i][1][3]);
            vo[0] = pk2(vv[i][0][0], vv[i][0][1]); vo[1] = pk2(vv[i][0][2], vv[i][0][3]); vo[2] = pk2(vv[i][1][0], vv[i][1][1]); vo[3] = pk2(vv[i][1][2], vv[i][1][3]);
            *(u32x4*)(KNG + (size_t)row * 256 + piece * 8) = ko; *(u32x4*)(VL + rr * 264 + piece * 8) = vo; }
    }
    __syncthreads();
    { const int gd = t & 255, half = t >> 8; unsigned pk[16];
#pragma unroll
      for (int q = 0; q < 16; ++q) { const unsigned lo = VL[(half * 32 + 2 * q) * 264 + gd], hi = VL[(half * 32 + 2 * q + 1) * 264 + gd]; pk[q] = lo | (hi << 16); }
      bf16_t* dst = VTG + (size_t)gd * TK + r0 + half * 32;
#pragma unroll
      for (int q = 0; q < 4; ++q) { u32x4 o; o[0] = pk[4 * q]; o[1] = pk[4 * q + 1]; o[2] = pk[4 * q + 2]; o[3] = pk[4 * q + 3]; *(u32x4*)(dst + 8 * q) = o; } }
    __syncthreads();
}

template <int KS1, int KS2>
__device__ __forceinline__ void attn_wg(const bf16_t* K1, int ld1, const bf16_t* K2, int ld2, const bf16x8 (&bq)[KS1 + KS2], const bf16_t* VT, int ldvt,
                                        int seg0_base, int seg0_tiles, int seg1_base, int tpq, float sc2, bf16_t* out, int ldo, unsigned char* shm) {
    constexpr int KLD = (KS1 + KS2) * 16 + 8, VLD = 36, KTILE = 32 * KLD, VTILE = 128 * VLD;
    bf16_t* Kl = (bf16_t*)shm; bf16_t* Vl = Kl + 4 * KTILE;
    const int t = tidx(), wv = t >> 6, lane = t & 63, r = lane & 31, h = lane >> 5, qblk = wv & 1, kq = wv >> 1;
    f32x16 oacc[4];
#pragma unroll
    for (int i = 0; i < 4; ++i) oacc[i] = zero16();
    float m = -1e30f, l = 0.f;
    u32x4 rk1[4], rk2[2], rv[4];
#define ATT_KB(q_, st_) ({ const int Tt_ = (q_) * tpq + (st_); Tt_ < seg0_tiles ? seg0_base + 32 * Tt_ : seg1_base + 32 * (Tt_ - seg0_tiles); })
#define ATT_LOAD(st_) do { \
        _Pragma("unroll") for (int i_ = 0; i_ < 4; ++i_) { const int kb_ = ATT_KB(i_, st_); \
            rk1[i_] = *(const u32x4*)(K1 + (size_t)(kb_ + (t >> 4)) * ld1 + (t & 15) * 8); \
            rv[i_] = *(const u32x4*)(VT + (size_t)(t >> 2) * ldvt + kb_ + (t & 3) * 8); } \
        if (KS2 > 0) { _Pragma("unroll") for (int i_ = 0; i_ < 2; ++i_) { const int kb_ = ATT_KB((t >> 8) + 2 * i_, st_); \
            rk2[i_] = *(const u32x4*)(K2 + (size_t)(kb_ + ((t & 255) >> 3)) * ld2 + (t & 7) * 8); } } } while (0)
    ATT_LOAD(0);
    for (int st = 0; st < tpq; ++st) {
#pragma unroll
        for (int i = 0; i < 4; ++i) { *(u32x4*)(Kl + i * KTILE + (t >> 4) * KLD + (t & 15) * 8) = rk1[i];
            bf16_t* vd = Vl + i * VTILE + (t >> 2) * VLD + (t & 3) * 8; u32x2 a, b; a[0] = rv[i][0]; a[1] = rv[i][1]; b[0] = rv[i][2]; b[1] = rv[i][3]; *(u32x2*)vd = a; *(u32x2*)(vd + 4) = b; }
        if (KS2 > 0) {
#pragma unroll
            for (int i = 0; i < 2; ++i) *(u32x4*)(Kl + ((t >> 8) + 2 * i) * KTILE + ((t & 255) >> 3) * KLD + KS1 * 16 + (t & 7) * 8) = rk2[i]; }
        __syncthreads();
        if (st + 1 < tpq) ATT_LOAD(st + 1);
        f32x16 s = zero16();
        { const bf16_t* kp = Kl + kq * KTILE + r * KLD + 8 * h;
#pragma unroll
          for (int ks = 0; ks < KS1 + KS2; ++ks) s = mfma32(*(const bf16x8*)(kp + ks * 16), bq[ks], s); }
        float tmax = s[0];
#pragma unroll
        for (int q = 1; q < 16; ++q) tmax = fmaxf(tmax, s[q]);
        tmax = fmaxf(tmax, __shfl_xor(tmax, 32, 64));
        const float mnew = fmaxf(m, tmax); const float alpha = __builtin_amdgcn_exp2f((m - mnew) * sc2); const float mb = mnew * sc2;
        float pr[16]; float rs = 0.f;
#pragma unroll
        for (int q = 0; q < 16; ++q) { pr[q] = __builtin_amdgcn_exp2f(s[q] * sc2 - mb); rs += pr[q]; }
        l = l * alpha + rs; m = mnew;
#pragma unroll
        for (int i = 0; i < 4; ++i) oacc[i] *= alpha;
        bf16x8 pb[2];
#pragma unroll
        for (int si = 0; si < 2; ++si) { u32x4 w; w[0] = pk2(pr[8 * si], pr[8 * si + 1]); w[1] = pk2(pr[8 * si + 2], pr[8 * si + 3]); w[2] = pk2(pr[8 * si + 4], pr[8 * si + 5]); w[3] = pk2(pr[8 * si + 6], pr[8 * si + 7]);
            pb[si] = __builtin_bit_cast(bf16x8, w); }
#pragma unroll
        for (int dt = 0; dt < 4; ++dt) { const bf16_t* vp = Vl + kq * VTILE + (dt * 32 + r) * VLD + 4 * h;
#pragma unroll
            for (int si = 0; si < 2; ++si) { const u32x2 lo = *(const u32x2*)(vp + 16 * si), hi = *(const u32x2*)(vp + 16 * si + 8);
                u32x4 w; w[0] = lo[0]; w[1] = lo[1]; w[2] = hi[0]; w[3] = hi[1];
                oacc[dt] = mfma32(__builtin_bit_cast(bf16x8, w), pb[si], oacc[dt]); } }
        __syncthreads();
    }
#undef ATT_LOAD
#undef ATT_KB
    float* OC = (float*)shm;
    float* ML = OC + 8 * 64 * 64;
    const float ltot = l + __shfl_xor(l, 32, 64);
    ML[(wv * 2 + 0) * 64 + lane] = m; ML[(wv * 2 + 1) * 64 + lane] = ltot;
    { float* oc = OC + (size_t)wv * 4096 + lane;
#pragma unroll
      for (int dt = 0; dt < 4; ++dt)
#pragma unroll
          for (int q = 0; q < 16; ++q) oc[(dt * 16 + q) * 64] = oacc[dt][q]; }
    __syncthreads();
    { float mk[4], lk[4]; float M = -1e30f;
#pragma unroll
      for (int k = 0; k < 4; ++k) { mk[k] = ML[((k * 2 + qblk) * 2 + 0) * 64 + lane]; lk[k] = ML[((k * 2 + qblk) * 2 + 1) * 64 + lane]; M = fmaxf(M, mk[k]); }
      float sk[4]; float L = 0.f;
#pragma unroll
      for (int k = 0; k < 4; ++k) { sk[k] = __builtin_amdgcn_exp2f((mk[k] - M) * sc2); L += sk[k] * lk[k]; }
      const float inv = 1.0f / L; const int dt = kq;
      float o[16];
#pragma unroll
      for (int q = 0; q < 16; ++q) { float v = 0.f;
#pragma unroll
          for (int k = 0; k < 4; ++k) v += sk[k] * OC[(size_t)(k * 2 + qblk) * 4096 + (dt * 16 + q) * 64 + lane];
          o[q] = v * inv; }
#pragma unroll
      for (int rg = 0; rg < 4; ++rg) { u32x2 w; w[0] = pk2(o[4 * rg], o[4 * rg + 1]); w[1] = pk2(o[4 * rg + 2], o[4 * rg + 3]);
          *(u32x2*)(out + (size_t)(qblk * 32 + r) * ldo + dt * 32 + 8 * rg + 4 * h) = w; } }
    __syncthreads();
}

__device__ __forceinline__ void gqa_attn_item(PRef p, int a, unsigned char* shm) {
    const int wv = tidx() >> 6, lane = tidx() & 63, r = lane & 31, h = lane >> 5;
    int hq, q0, s0b, s0t, s1b, tpq;
    if (a < 128) { const int b = a >> 6; hq = (a >> 4) & 3; const int qb = a & 15; q0 = 4096 + b * 1024 + qb * 64; s0b = T + b * 512; s0t = 16; s1b = 4096 + b * 1024; tpq = 12; }
    else { const int aa = a - 128; const int b = aa >> 4; hq = (aa >> 2) & 3; const int qb = aa & 3; q0 = b * 256 + qb * 64; s0b = b * 256; s0t = 8; s1b = 0; tpq = 2; }
    const int g = hq >> 1;
    const bf16_t* QNG = (const bf16_t*)(p.ws + WS_QNG); const bf16_t* KNG = (const bf16_t*)(p.ws + WS_KNG); const bf16_t* VTG = (const bf16_t*)(p.ws + WS_VTG);
    bf16_t* MIX = (bf16_t*)(p.ws + WS_MIX);
    bf16x8 bq[8];
    const bf16_t* qp = QNG + (size_t)(q0 + (wv & 1) * 32 + r) * 512 + hq * 128 + 8 * h;
#pragma unroll
    for (int ks = 0; ks < 8; ++ks) bq[ks] = *(const bf16x8*)(qp + ks * 16);
    attn_wg<8, 0>(KNG + g * 128, 256, nullptr, 0, bq, VTG + (size_t)g * 128 * TK, TK, s0b, s0t, s1b, tpq, 0.08838834764831845f * 1.4426950408889634f,
                  MIX + (size_t)q0 * 1024 + 512 + hq * 128, 1024, shm);
}
__device__ __forceinline__ void mla_attn_item(PRef p, int j, int a, unsigned char* shm) {
    const int wv = tidx() >> 6, lane = tidx() & 63, r = lane & 31, h = lane >> 5;
    int hd, q0, s0b, s0t, s1b, tpq; bool samp;
    if (a < 128) { const int b = a >> 6; hd = (a >> 4) & 3; const int qb = a & 15; q0 = 4096 + b * 1024 + qb * 64; s0b = T + b * 512; s0t = 16; s1b = 4096 + b * 1024; tpq = 12; samp = true; }
    else { const int aa = a - 128; const int b = aa >> 4; hd = (aa >> 2) & 3; const int qb = aa & 3; q0 = b * 256 + qb * 64; s0b = b * 256; s0t = 8; s1b = 0; tpq = 2; samp = false; }
    const bf16_t* QM = (const bf16_t*)(p.ws + WS_QMLA); const bf16_t* KN = (const bf16_t*)(p.ws + WS_KNOPE); const bf16_t* KPE = (const bf16_t*)(p.ws + WS_KPE) + (size_t)j * TK * 64;
    const bf16_t* VTM = (const bf16_t*)(p.ws + WS_VTM); bf16_t* MIX = (bf16_t*)(p.ws + WS_MIX);
    bf16x8 bq[12];
    const int qrow = q0 + (wv & 1) * 32 + r;
    const bf16_t* qp = QM + (size_t)qrow * 768 + hd * 192 + 8 * h;
#pragma unroll
    for (int ks = 0; ks < 12; ++ks) bq[ks] = *(const bf16x8*)(qp + ks * 16);
    if (samp) { const int tt = (qrow - 4096) & 1023; const float prow = (float)(tt >> 6), pcol = (float)(tt & 63);
#pragma unroll
        for (int ksp = 0; ksp < 2; ++ksp) { bf16x8 x1 = bq[8 + ksp], x2 = bq[10 + ksp];
#pragma unroll
            for (int jj = 0; jj < 8; ++jj) { const int i = 16 * ksp + 8 * h + jj; const float inv = exp2f(-(float)(i & 15) * (13.287712379549449f / 16.0f)); const float ang = (i < 16 ? prow : pcol) * inv;
                const float cs = __cosf(ang), sn = __sinf(ang); const float a1 = bf2f((bf16_t)x1[jj]), a2 = bf2f((bf16_t)x2[jj]);
                x1[jj] = (short)f2bf(a1 * cs - a2 * sn); x2[jj] = (short)f2bf(a1 * sn + a2 * cs); }
            bq[8 + ksp] = x1; bq[10 + ksp] = x2; } }
    attn_wg<8, 4>(KN + hd * 128, 512, KPE, 64, bq, VTM + (size_t)hd * 128 * TK, TK, s0b, s0t, s1b, tpq, 0.07216878364870322f * 1.4426950408889634f,
                  MIX + (size_t)q0 * 1024 + 512 + hd * 128, 1024, shm);
}

__device__ __forceinline__ void odd_prep(PRef p, int j, int rb, unsigned char* shm) {
    const int t = tidx(), lane = t & 63, wv = t >> 6; const int r0 = rb * 16;
    const bf16_t* PROJ = (const bf16_t*)(p.ws + WS_PROJ);
    bf16_t* X0 = (bf16_t*)(p.ws + WS_X0); bf16_t* GV = (bf16_t*)(p.ws + WS_GV); bf16_t* GVT = (bf16_t*)(p.ws + WS_GVT);
    bf16_t* GL = (bf16_t*)shm;
    { const int ch = t; float w[3][3], bb[3];
      const int L = r0 < 4096 ? 256 : 1024; const int tt0 = r0 < 4096 ? (r0 & 255) : ((r0 - 4096) & 1023);
      bf16_t u[3][18];
#pragma unroll
      for (int part = 0; part < 3; ++part) { bb[part] = p.in[23][j * 1536 + part * 512 + ch];
#pragma unroll
          for (int tap = 0; tap < 3; ++tap) w[part][tap] = p.in[22][((size_t)j * 3 + tap) * 1536 + part * 512 + ch];
#pragma unroll
          for (int q = 0; q < 18; ++q) { const bool ok = (q == 0) ? (tt0 > 0) : ((q == 17) ? (tt0 + 16 < L) : true);
              u[part][q] = ok ? PROJ[(size_t)(r0 - 1 + q) * 2048 + part * 512 + ch] : (bf16_t)0; } }
#pragma unroll
      for (int rr = 0; rr < 16; ++rr) { const int row = r0 + rr;
          float o[3];
#pragma unroll
          for (int part = 0; part < 3; ++part) o[part] = bf2f(u[part][rr]) * w[part][0] + bf2f(u[part][rr + 1]) * w[part][1] + bf2f(u[part][rr + 2]) * w[part][2] + bb[part];
          const bf16_t gvb = f2bf(o[1] * o[2]);
          X0[(size_t)row * 512 + ch] = f2bf(o[0]); GV[(size_t)row * 512 + ch] = gvb; GL[rr * 520 + ch] = gvb; } }
    __syncthreads();
    { const int ch = t; bf16_t* dst = GVT + (size_t)ch * T + r0;
#pragma unroll
      for (int q = 0; q < 2; ++q) { u32x4 o;
#pragma unroll
          for (int z = 0; z < 4; ++z) { const unsigned lo = GL[(8 * q + 2 * z) * 520 + ch], hi = GL[(8 * q + 2 * z + 1) * 520 + ch]; o[z] = lo | (hi << 16); }
          *(u32x4*)(dst + 8 * q) = o; } }
    bf16_t* CQN = (bf16_t*)(p.ws + WS_CQN); bf16_t* CKV = (bf16_t*)(p.ws + WS_CKV) + (size_t)j * TK * 256; bf16_t* KPE = (bf16_t*)(p.ws + WS_KPE) + (size_t)j * TK * 64;
    for (int rr = wv; rr < 16; rr += 8) { const int row = r0 + rr; const bf16_t* pr = PROJ + (size_t)row * 2048;
        { float v[4]; float ss = 0.f;
#pragma unroll
          for (int q = 0; q < 4; ++q) { v[q] = bf2f(pr[1536 + lane * 4 + q]); ss += v[q] * v[q]; }
          ss = wave_sum(ss); const float rstd = rsqrtf(ss * (1.0f / 256.0f) + EPS); const f32x4 g = *(const f32x4*)(p.in[31] + j * 256 + lane * 4);
          u32x2 o; o[0] = pk2(v[0] * rstd * g[0], v[1] * rstd * g[1]); o[1] = pk2(v[2] * rstd * g[2], v[3] * rstd * g[3]);
          *(u32x2*)(CQN + (size_t)row * 256 + lane * 4) = o; }
        { float v0 = bf2f(pr[1792 + lane * 2]), v1 = bf2f(pr[1792 + lane * 2 + 1]); const float ss = wave_sum(v0 * v0 + v1 * v1); const float rstd = rsqrtf(ss * (1.0f / 128.0f) + EPS);
          v0 = v0 * rstd * p.in[33][j * 128 + lane * 2]; v1 = v1 * rstd * p.in[33][j * 128 + lane * 2 + 1];
          *(unsigned*)(CKV + (size_t)row * 256 + lane * 2) = pk2(v0, v1);
          if (row < 4096) { const int b = row >> 8, tt = row & 255; float* o = p.out + O_CKV + ((size_t)(b * 2 + j) * 256 + tt) * 128 + lane * 2; o[0] = v0; o[1] = v1; } }
        { float v = bf2f(pr[1920 + lane]);
          if (row < 4096) { const int b = row >> 8, tt = row & 255; p.out[O_KPE + ((size_t)(b * 2 + j) * 256 + tt) * 64 + lane] = v; }
          else { const int tt = (row - 4096) & 1023; const float other = __shfl_xor(v, 32, 64); const int i = lane & 31;
              const float inv = exp2f(-(float)(i & 15) * (13.287712379549449f / 16.0f)); const float ang = (i < 16 ? (float)(tt >> 6) : (float)(tt & 63)) * inv; const float cs = __cosf(ang), sn = __sinf(ang);
              v = lane < 32 ? v * cs - other * sn : other * sn + v * cs; }
          KPE[(size_t)row * 64 + lane] = f2bf(v); } }
    __syncthreads();
}

__device__ __forceinline__ void hyena_conv(PRef p, int j, int type, int half, int cg8, unsigned char* shm) {
    const int t = tidx(), lane = t & 63, wv = t >> 6, r = lane & 31, h = lane >> 5;
    const int L = type ? 1024 : 256, nb = L >> 5, tbase = type ? 4096 : half * 2048;
    bf16_t* OUT = (bf16_t*)shm;
    bf16_t* GRL = (bf16_t*)(shm + 32768) + wv * 2048;
    bf16_t* GVL = (bf16_t*)(shm + 65536) + wv * 2048;
    bf16_t* ZR = (bf16_t*)(shm + 98304);
    const int ch = cg8 * 8 + wv;
    const bf16_t* gr = (const bf16_t*)(p.ws + WS_GR) + (size_t)j * 512 * 2560 + (type ? (size_t)512 * 512 : 0) + (size_t)ch * (2 * L);
    for (int i = lane; i < (2 * L) / 8; i += 64) *(u32x4*)(GRL + i * 8) = *(const u32x4*)(gr + i * 8);
    const bf16_t* gvt = (const bf16_t*)(p.ws + WS_GVT) + (size_t)ch * T + tbase;
    for (int i = lane; i < 256; i += 64) *(u32x4*)(GVL + i * 8) = *(const u32x4*)(gvt + i * 8);
    if (t < 8) ((unsigned*)ZR)[t] = 0u;
    __syncthreads();
    f32x16 acc[2];
    acc[0] = zero16(); acc[1] = zero16();
    int cola[2], colb[2];
#pragma unroll
    for (int nt = 0; nt < 2; ++nt) { const int n = 32 * nt + r; const int batch = n / nb, a = n % nb; cola[nt] = a; colb[nt] = batch * L + 8 * h; }
    const volatile LAS bf16_t* grl = (const volatile LAS bf16_t*)(LAS bf16_t*)GRL;
    const int nit = (2 * nb - 1) * 2;
    const int mbase = (L - 1) - r + 8 * h;
    bf16x8 afc, bfc[2];
#define HY_LOAD(it_, af_, bf_) do { const int dl_ = ((it_) >> 1) - (nb - 1), kk_ = (it_) & 1; const int m0_ = mbase - 32 * dl_ + 16 * kk_; \
        _Pragma("unroll") for (int jj = 0; jj < 8; ++jj) af_[jj] = (short)grl[m0_ + jj]; \
        _Pragma("unroll") for (int nt = 0; nt < 2; ++nt) { const int ab_ = cola[nt] - dl_; \
            const bf16_t* bp_ = (ab_ >= 0 && ab_ < nb) ? GVL + colb[nt] + 32 * ab_ + 16 * kk_ : ZR; bf_[nt] = *(const bf16x8*)bp_; } } while (0)
    HY_LOAD(0, afc, bfc);
    for (int it = 0; it < nit; ++it) {
        bf16x8 afn = afc, bfn[2] = {bfc[0], bfc[1]};
        if (it + 1 < nit) HY_LOAD(it + 1, afn, bfn);
        acc[0] = mfma32(afc, bfc[0], acc[0]); acc[1] = mfma32(afc, bfc[1], acc[1]);
        afc = afn; bfc[0] = bfn[0]; bfc[1] = bfn[1];
    }
#undef HY_LOAD
#pragma unroll
    for (int nt = 0; nt < 2; ++nt) { const int n = 32 * nt + r; const int batch = n / nb, a = n % nb;
#pragma unroll
        for (int q = 0; q < 16; ++q) { const int i = (q & 3) + 8 * (q >> 2) + 4 * h; OUT[(batch * L + 32 * a + i) * 8 + wv] = f2bf(acc[nt][q]); } }
    __syncthreads();
    const bf16_t* X0 = (const bf16_t*)(p.ws + WS_X0); const bf16_t* GV = (const bf16_t*)(p.ws + WS_GV); bf16_t* MIX = (bf16_t*)(p.ws + WS_MIX);
    float sk[8];
#pragma unroll
    for (int q = 0; q < 8; ++q) sk[q] = p.in[24][j * 512 + cg8 * 8 + q];
    for (int tl = t; tl < 2048; tl += 512) { const int row = tbase + tl;
        const bf16x8 y = *(const bf16x8*)(OUT + tl * 8), x0 = *(const bf16x8*)(X0 + (size_t)row * 512 + cg8 * 8), gv = *(const bf16x8*)(GV + (size_t)row * 512 + cg8 * 8);
        float o[8];
#pragma unroll
        for (int q = 0; q < 8; ++q) o[q] = bf2f((bf16_t)x0[q]) * (bf2f((bf16_t)y[q]) + bf2f((bf16_t)gv[q]) * sk[q]);
        u32x4 w; w[0] = pk2(o[0], o[1]); w[1] = pk2(o[2], o[3]); w[2] = pk2(o[4], o[5]); w[3] = pk2(o[6], o[7]);
        *(u32x4*)(MIX + (size_t)row * 1024 + cg8 * 8) = w; }
    __syncthreads();
}

#define XB_TMO      128
#define XB_XCNT(j)  (256  + 64 * (j))
#define XB_XSUB(j)  (1280 + 64 * (j))
#define XB_XGEN(j)  (2304 + 64 * (j))
#define XB_TOP      3328
#define XB_TOPGEN   3392
#define XCD_BAR_WORDS 3456
#define XB_SPIN_CAP (1u << 22)
__device__ __forceinline__ unsigned xb_ld(unsigned* p)              { return __hip_atomic_load(p, __ATOMIC_RELAXED, __HIP_MEMORY_SCOPE_AGENT); }
__device__ __forceinline__ unsigned xb_add(unsigned* p, unsigned v) { return __hip_atomic_fetch_add(p, v, __ATOMIC_RELAXED, __HIP_MEMORY_SCOPE_AGENT); }
__device__ __forceinline__ unsigned xb_xcc_id() { return (unsigned)__builtin_amdgcn_s_getreg((3 << 11) | 20) & 0xFu; }
#define XB_SPIN(cond, bar) do { unsigned _sp = 0; while (cond) { __builtin_amdgcn_s_sleep(1); \
    if ((++_sp & 255u) == 0u) { if (xb_ld(&(bar)[XB_TMO])) break; if (_sp > XB_SPIN_CAP) { atomicAdd(&(bar)[XB_TMO], 1u); break; } } } } while (0)
struct XcdBarrier { unsigned* bar; unsigned x; volatile LAS unsigned* st; };
__device__ __forceinline__ XcdBarrier xcd_barrier_post(unsigned* bar, volatile LAS unsigned* st) {
    XcdBarrier b; b.bar = bar; b.x = xb_xcc_id(); b.st = st;
    if (threadIdx.x == 0) (void)xb_add(&bar[XB_XCNT(b.x)], 1u);
    return b;
}
__device__ __forceinline__ void xcd_barrier_complete(unsigned* bar, unsigned x, unsigned& nloc, unsigned& nx) {
    const unsigned G = gridDim.x * gridDim.y * gridDim.z;
    unsigned sum, cnt, mine, sp = 0u;
    for (;;) {
        sum = 0u; cnt = 0u; mine = 0u;
#pragma unroll
        for (unsigned j = 0; j < 16; ++j) { const unsigned c = xb_ld(&bar[XB_XCNT(j)]); sum += c; cnt += (c > 0u) ? 1u : 0u; mine = (j == x) ? c : mine; }
        if (sum == G) break;
        __builtin_amdgcn_s_sleep(1);
        if ((++sp & 255u) == 0u) { if (xb_ld(&bar[XB_TMO])) break; if (sp > XB_SPIN_CAP) { atomicAdd(&bar[XB_TMO], 1u); break; } }
    }
    nloc = mine > 0u ? mine : 1u; nx = cnt > 0u ? cnt : 1u;
}
__device__ __forceinline__ void xcd_barrier(const XcdBarrier& b) {
    asm volatile("s_waitcnt vmcnt(0)" ::: "memory");
    __syncthreads();
    if (threadIdx.x == 0) {
        unsigned* bar = b.bar;
        __builtin_amdgcn_s_waitcnt(0);
        unsigned nloc = b.st[0], nx = b.st[1];
        if (nloc == 0u) { xcd_barrier_complete(bar, b.x, nloc, nx); b.st[0] = nloc; b.st[1] = nx; }
        const unsigned old = xb_add(&bar[XB_XSUB(b.x)], 1u);
        const unsigned gen = old / nloc;
        if (old + 1u == (gen + 1u) * nloc) {
            __builtin_amdgcn_fence(__ATOMIC_RELEASE, "agent");
            asm volatile("s_waitcnt vmcnt(0)" ::: "memory");
            const unsigned og = xb_add(&bar[XB_TOP], 1u);
            const unsigned tg = og / nx;
            if (og + 1u == (tg + 1u) * nx) xb_add(&bar[XB_TOPGEN], 1u);
            else XB_SPIN(xb_ld(&bar[XB_TOPGEN]) == tg, bar);
            __builtin_amdgcn_fence(__ATOMIC_ACQUIRE, "agent");
            xb_add(&bar[XB_XGEN(b.x)], 1u);
            asm volatile("s_waitcnt vmcnt(0)" ::: "memory");
        } else {
            XB_SPIN(xb_ld(&bar[XB_XGEN(b.x)]) == gen, bar);
            __builtin_amdgcn_fence(__ATOMIC_ACQUIRE, "agent");
            asm volatile("s_waitcnt vmcnt(0)" ::: "memory");
        }
    }
    __syncthreads();
}

__device__ __forceinline__ int next_item(unsigned* q, volatile LAS unsigned* slot) {
    if (threadIdx.x == 0) *slot = __hip_atomic_fetch_add(q, 1u, __ATOMIC_RELAXED, __HIP_MEMORY_SCOPE_AGENT);
    __syncthreads();
    const int it = (int)*slot;
    __syncthreads();
    return it;
}

extern __shared__ __attribute__((aligned(16))) unsigned char g_shm[];

enum { K_PREP = 0, K_NORM, K_GS, K_E2, K_E3, K_O2, K_O4, K_GR_UNUSED, K_F1 };
__device__ __forceinline__ void decode_phase(int ph, int& kind, int& l, int& var) {
    if (ph == 0) { kind = K_PREP; l = 0; var = 0; return; }
    if (ph == N_PHASES - 1) { kind = K_NORM; l = 0; var = 2; return; }
    int q = ph - 1;
    if (q < 8) l = 0; else if (q < 17) { l = 1; q -= 8; } else if (q < 25) { l = 2; q -= 17; } else { l = 3; q -= 25; }
    if ((l & 1) == 0) {
        switch (q) { case 0: kind = K_NORM; var = 0; break; case 1: kind = K_GS; var = 0; break; case 2: kind = K_E2; var = 0; break; case 3: kind = K_E3; var = 0; break;
                     case 4: kind = K_GS; var = 3; break; case 5: kind = K_NORM; var = 1; break; case 6: kind = K_F1; var = 0; break; default: kind = K_GS; var = 4; break; }
    } else {
        switch (q) { case 0: kind = K_NORM; var = 0; break; case 1: kind = K_GS; var = 1; break; case 2: kind = K_O2; var = 0; break; case 3: kind = K_GS; var = 2; break; case 4: kind = K_O4; var = 0; break;
                     case 5: kind = K_GS; var = 3; break; case 6: kind = K_NORM; var = 1; break; case 7: kind = K_F1; var = 0; break; default: kind = K_GS; var = 4; break; }
    }
}

__global__ void __launch_bounds__(512, 2) mega(Params p_arg) {
    cg::grid_group grid = cg::this_grid();
    const int ph_lo = get_params()->ph_lo, ph_hi = get_params()->ph_hi;
    volatile LAS unsigned* xb_st = (volatile LAS unsigned*)((LAS unsigned char*)g_shm + (LDS_BYTES - 16));
    XcdBarrier xb; xb.bar = (unsigned*)(get_params()->ws + WS_BAR); xb.x = 0; xb.st = xb_st;
    if (ph_hi - ph_lo > 1) { if (threadIdx.x == 0) { xb_st[0] = 0u; xb_st[1] = 0u; } __syncthreads(); xb = xcd_barrier_post(xb.bar, xb_st); }
    for (int ph = ph_lo; ph < ph_hi; ++ph) {
        PRef p = *get_params();
        unsigned char* shm = g_shm;
        LAS unsigned char* lds = (LAS unsigned char*)g_shm;
        const int wg = bidx(), G = gdim();
        unsigned char* ws = p.ws;
        int kind, l, var; decode_phase(ph, kind, l, var);
        const int j = l >> 1;
        const int nrep = (kind == REP_KIND && (REP_VAR < 0 || var == REP_VAR)) ? 1 + REP_N : 1;
        for (int rep = 0; rep < nrep; ++rep)
        switch (kind) {
        case K_PREP: phase_prep(p, shm); break;
        case K_NORM: phase_norm(p, l, var); break;
        case K_GS: {
            const int nsub = var == 2 ? 3 : 1;
            if (var == 0) phase_zgemm(p, j, shm);
            for (int gi = 0; gi < nsub; ++gi) {
                pg8::Gemm g; pg8::EpiStore E; int c = wg, GG = G, ns = 1, ksub = 0;
                if (var == 3) { g = {(const bf16_t*)(ws + WS_MIX), (const bf16_t*)(ws + ((l & 1) ? WS_WOUTO : WS_WOUTE)) + (size_t)j * 1024 * 1024, T, 1024, 512, 1024}; E = {(bf16_t*)(ws + WS_P), 1024, 1024, (size_t)T * 1024}; ns = 2; ksub = 512; }
                else if (var == 4) { g = {(const bf16_t*)(ws + WS_ACT), (const bf16_t*)(ws + WS_WFO) + (size_t)l * 1024 * 2816, T, 1024, 1408, 2816}; E = {(bf16_t*)(ws + WS_P), 1024, 1024, (size_t)T * 1024}; ns = 2; ksub = 1408; }
                else if (var == 0) { g = {(const bf16_t*)(ws + WS_H), (const bf16_t*)(ws + WS_WINE) + (size_t)j * 2560 * 1024, T, 2560, 1024, 1024}; E = {(bf16_t*)(ws + WS_PROJ), 2560, 2560, 0}; }
                else if (var == 1) { g = {(const bf16_t*)(ws + WS_H), (const bf16_t*)(ws + WS_WINO) + (size_t)j * 2048 * 1024, T, 2048, 1024, 1024}; E = {(bf16_t*)(ws + WS_PROJ), 2048, 1984, 0}; }
                else {
                    int off;
                    if (gi == 0) { g = {(const bf16_t*)(ws + WS_CQN), (const bf16_t*)(ws + WS_WQB) + (size_t)j * 768 * 256, T, 768, 256, 256}; E = {(bf16_t*)(ws + WS_QMLA), 768, 768, 0}; off = 0; }
                    else if (gi == 1) { g = {(const bf16_t*)(ws + WS_CKV) + (size_t)j * TK * 256, (const bf16_t*)(ws + WS_WKVK) + (size_t)j * 512 * 256, TK, 512, 256, 256}; E = {(bf16_t*)(ws + WS_KNOPE), 512, 512, 0}; off = 72; }
                    else { g = {(const bf16_t*)(ws + WS_WKVV) + (size_t)j * 512 * 256, (const bf16_t*)(ws + WS_CKV) + (size_t)j * TK * 256, 512, TK, 256, 256}; E = {(bf16_t*)(ws + WS_VTM), TK, TK, 0}; off = 128; }
                    if (G >= 184) { c = wg - off; GG = 256; }
                }
                pg8::Order S; S.init(g.M, g.N, GG, c, ns, ksub);
                pg8::gemm_phase(lds, g, S, E);
            }
            if (var == 4 && l < 3 && G == 256) { if (wg >= 192) conv_layer(p, l + 1, wg - 192, 64, (float*)shm, 2); }
        } break;
        case K_E2: {
            unsigned* q = (unsigned*)(ws + WS_BAR) + 16 + l * 4; volatile LAS unsigned* slot = (volatile LAS unsigned*)((LAS unsigned char*)g_shm + (LDS_BYTES - 32));
            for (;;) { const int it = next_item(q, slot); if (it >= 880) break; if (it < 112) gqa_prep(p, j, it, shm); else gla_pass_a(p, j, it - 112, shm); }
        } break;
        case K_E3: {
            unsigned* q = (unsigned*)(ws + WS_BAR) + 17 + l * 4; volatile LAS unsigned* slot = (volatile LAS unsigned*)((LAS unsigned char*)g_shm + (LDS_BYTES - 32));
            for (;;) { const int it = next_item(q, slot); if (it >= 768) break;
                if (it < 128 || (it >= 256 && it < 512)) gla_pass_b(p, j, it < 128 ? 256 + it : it - 256, shm); else gqa_attn_item(p, it < 256 ? it - 128 : it - 384, shm); }
        } break;
        case K_O2:
            for (int it = wg; it < 384; it += G) odd_prep(p, j, it, shm);
            break;
        case K_O4: {
            unsigned* q = (unsigned*)(ws + WS_BAR) + 18 + l * 4; volatile LAS unsigned* slot = (volatile LAS unsigned*)((LAS unsigned char*)g_shm + (LDS_BYTES - 32));
            for (;;) { const int it = next_item(q, slot); if (it >= 576) break;
                if (it < 192) hyena_conv(p, j, it < 64 ? 1 : 0, it < 64 ? 0 : (it - 64) >> 6, it < 64 ? it : (it - 64) & 63, shm);
                else mla_attn_item(p, j, it - 192, shm); }
        } break;
        default: {
            pg8::Gemm g{(const bf16_t*)(ws + WS_H), (const bf16_t*)(ws + WS_WFI) + (size_t)l * 5632 * 1024, T, 5632, 1024, 1024};
            pg8::Order S; S.init(T, 5632, G, wg); pg8::EpiSwiglu E{(bf16_t*)(ws + WS_ACT)};
            pg8::gemm_phase(lds, g, S, E);
            if (l < 3) {
                const int nlast = 528 - 2 * G;
                if (G == 256 && nlast > 0) { if (wg >= nlast) conv_layer(p, l + 1, wg - nlast, G - nlast, (float*)shm, 1); }
                else conv_layer(p, l + 1, wg, G, (float*)shm); }
        } break;
        }
        if (ph + 1 < ph_hi) { if (USE_CG_SYNC || ph_hi > 100000) grid.sync(); else xcd_barrier(xb); }
        for (int es = 0; es < EXTRA_SYNC; ++es) xcd_barrier(xb);
    }
}

extern "C" void kernel_launch(void* const* d_in, const int* in_sizes, int n_in, void* d_out, int out_size, void* d_ws, size_t ws_size, hipStream_t stream) {
    static int grid = 0;
    if (grid == 0) {
        if (n_in != NIN || ws_size < WS_END) { fprintf(stderr, "kernel_launch: unexpected n_in %d / ws_size %zu (need %zu)\n", n_in, ws_size, (size_t)WS_END); grid = -1; return; }
        int dev = 0, cus = 0, per_cu = 0;
        hipGetDevice(&dev); hipDeviceGetAttribute(&cus, hipDeviceAttributeMultiprocessorCount, dev);
        if (hipFuncSetAttribute((const void*)mega, hipFuncAttributeMaxDynamicSharedMemorySize, LDS_BYTES) != hipSuccess) { fprintf(stderr, "kernel_launch: hipFuncSetAttribute failed\n"); grid = -1; return; }
        if (hipOccupancyMaxActiveBlocksPerMultiprocessor(&per_cu, (const void*)mega, 512, LDS_BYTES) != hipSuccess || per_cu < 1) { fprintf(stderr, "kernel_launch: occupancy query says %d\n", per_cu); per_cu = 1; }
        (void)hipGetLastError();
        grid = cus;
        if (grid > 256) grid = 256;
    }
    if (grid < 0) return;
    Params p{};
    for (int i = 0; i < NIN; ++i) p.in[i] = (const float*)d_in[i];
    p.out = (float*)d_out; p.ws = (unsigned char*)d_ws;
#if MULTI_LAUNCH
    for (int ph = 0; ph < N_PHASES; ++ph) { p.ph_lo = ph; p.ph_hi = ph + 1; hipLaunchKernelGGL(mega, dim3(grid), dim3(512), LDS_BYTES, stream, p); }
#else
    p.ph_lo = 0; p.ph_hi = N_PHASES;
    if (hipMemsetAsync((unsigned char*)d_ws + WS_BAR, 0, 16384, stream) != hipSuccess) { fprintf(stderr, "kernel_launch: memset of barrier words failed\n"); return; }
    void* args[] = {&p};
    hipError_t e = hipLaunchCooperativeKernel((const void*)mega, dim3(grid), dim3(512), args, LDS_BYTES, stream);
    if (e != hipSuccess) fprintf(stderr, "cooperative launch failed: %s (grid %d)\n", hipGetErrorString(e), grid);
#endif
}
```

```cpp
#include <hip/hip_runtime.h>
#include <hip/hip_cooperative_groups.h>
#include <cstdio>
namespace cg = cooperative_groups;

#ifndef REP_KIND
#define REP_KIND -1
#endif
#ifndef REP_VAR
#define REP_VAR -1
#endif
#ifndef REP_N
#define REP_N 0
#endif
#ifndef REP_SUB
#define REP_SUB 0
#endif
#ifndef USE_CG_SYNC
#define USE_CG_SYNC 0
#endif
#ifndef EXTRA_SYNC
#define EXTRA_SYNC 0
#endif
#ifndef MULTI_LAUNCH
#define MULTI_LAUNCH 0
#endif

#define LAS __attribute__((address_space(3)))
typedef unsigned short bf16_t;
typedef short bf16x8 __attribute__((ext_vector_type(8)));
typedef float f32x4 __attribute__((ext_vector_type(4)));
typedef float f32x16 __attribute__((ext_vector_type(16)));
typedef unsigned u32x4 __attribute__((ext_vector_type(4)));
typedef unsigned u32x2 __attribute__((ext_vector_type(2)));

constexpr int T = 6144, TK = 7168;
constexpr int NIN = 39;
constexpr float EPS = 1e-6f;
constexpr int N_PHASES = 36;

constexpr size_t O_YP = 0, O_YS = 4194304, O_SF = 6291456, O_SB = 7340032, O_CK = 8388608, O_CV = 10485760, O_CKV = 12582912, O_KPE = 13631488;

constexpr size_t al256(size_t x) { return (x + 255) & ~(size_t)255; }
constexpr size_t WS_X = 0;
constexpr size_t WS_H = WS_X + al256((size_t)T * 1024 * 4);
constexpr size_t WS_MOD = WS_H + al256((size_t)T * 1024 * 2);
constexpr size_t WS_PROJ = WS_MOD + al256((size_t)4 * 3 * 6144 * 4);
constexpr size_t WS_ZG = WS_PROJ + al256((size_t)T * 2560 * 2);
constexpr size_t WS_WZ = WS_ZG + al256((size_t)T * 32 * 4);
constexpr size_t WS_MIX = WS_WZ + al256((size_t)2 * 32 * 1024 * 2);
constexpr size_t WS_ACT = WS_MIX + al256((size_t)T * 1024 * 2);
constexpr size_t WS_WINE = WS_ACT + al256((size_t)T * 2816 * 2);
constexpr size_t WS_WOUTE = WS_WINE + al256((size_t)2 * 2560 * 1024 * 2);
constexpr size_t WS_WINO = WS_WOUTE + al256((size_t)2 * 1024 * 1024 * 2);
constexpr size_t WS_WOUTO = WS_WINO + al256((size_t)2 * 2048 * 1024 * 2);
constexpr size_t WS_WQB = WS_WOUTO + al256((size_t)2 * 1024 * 1024 * 2);
constexpr size_t WS_WKVK = WS_WQB + al256((size_t)2 * 768 * 256 * 2);
constexpr size_t WS_WKVV = WS_WKVK + al256((size_t)2 * 512 * 256 * 2);
constexpr size_t WS_WFI = WS_WKVV + al256((size_t)2 * 512 * 256 * 2);
constexpr size_t WS_WFO = WS_WFI + al256((size_t)4 * 5632 * 1024 * 2);
constexpr size_t WS_DS = WS_WFO + al256((size_t)4 * 1024 * 2816 * 2);
constexpr size_t WS_DEC = WS_DS + al256((size_t)768 * 64 * 128 * 4);
constexpr size_t WS_QNG = WS_DEC + al256((size_t)768 * 64 * 4);
constexpr size_t WS_KNG = WS_QNG + al256((size_t)T * 512 * 2);
constexpr size_t WS_VTG = WS_KNG + al256((size_t)TK * 256 * 2);
constexpr size_t WS_GR = WS_VTG + al256((size_t)256 * TK * 2);
constexpr size_t WS_X0 = WS_GR + al256((size_t)2 * 512 * 2560 * 2);
constexpr size_t WS_GV = WS_X0 + al256((size_t)T * 512 * 2);
constexpr size_t WS_GVT = WS_GV + al256((size_t)T * 512 * 2);
constexpr size_t WS_CQN = WS_GVT + al256((size_t)512 * T * 2);
constexpr size_t WS_CKV = WS_CQN + al256((size_t)T * 256 * 2);
constexpr size_t WS_KPE = WS_CKV + al256((size_t)2 * TK * 256 * 2);
constexpr size_t WS_QMLA = WS_KPE + al256((size_t)2 * TK * 64 * 2);
constexpr size_t WS_KNOPE = WS_QMLA + al256((size_t)T * 768 * 2);
constexpr size_t WS_VTM = WS_KNOPE + al256((size_t)TK * 512 * 2);
constexpr size_t WS_BAR = WS_VTM + al256((size_t)512 * TK * 2);
constexpr size_t WS_P = WS_BAR + 16384;
constexpr size_t WS_END = WS_P + al256((size_t)2 * T * 1024 * 2);

constexpr int LDS_BYTES = 139264;

struct Params {
    const float* in[NIN];
    float* out;
    unsigned char* ws;
    int ph_lo, ph_hi;
};

typedef const __attribute__((address_space(4))) Params& PRef;
typedef const __attribute__((address_space(4))) Params* PPtr;
__device__ __forceinline__ PPtr get_params() { PPtr q = (PPtr)__builtin_amdgcn_kernarg_segment_ptr(); asm volatile("" : "+s"(q)); return q; }

__device__ __forceinline__ int tidx() { int t = (int)__builtin_amdgcn_workitem_id_x(); asm volatile("" : "+v"(t)); return t; }
__device__ __forceinline__ int bidx() { int t = (int)__builtin_amdgcn_workgroup_id_x(); asm volatile("" : "+s"(t)); return t; }
__device__ __forceinline__ int gdim() { int t = (int)__ockl_get_num_groups(0); asm volatile("" : "+s"(t)); return t; }
__device__ __forceinline__ bf16_t f2bf(float f) { unsigned u = __float_as_uint(f); u += 0x7FFFu + ((u >> 16) & 1u); return (bf16_t)(u >> 16); }
__device__ __forceinline__ float bf2f(bf16_t b) { return __uint_as_float(((unsigned)b) << 16); }
typedef __bf16 bf16v2_t __attribute__((ext_vector_type(2)));
typedef float f32v2_t __attribute__((ext_vector_type(2)));
__device__ __forceinline__ unsigned pk2(float lo, float hi) { f32v2_t v; v[0] = lo; v[1] = hi; return __builtin_bit_cast(unsigned, __builtin_convertvector(v, bf16v2_t)); }
__device__ __forceinline__ float wave_sum(float v) {
#pragma unroll
    for (int o = 32; o > 0; o >>= 1) v += __shfl_xor(v, o, 64);
    return v;
}
__device__ __forceinline__ float silu_f(float g) { return g * __builtin_amdgcn_rcpf(1.0f + __expf(-g)); }
__device__ __forceinline__ int cvec_of(int r) { return r < 4096 ? 0 : 1 + ((r - 4096) >> 10); }
__device__ __forceinline__ f32x16 zero16() { f32x16 z;
#pragma unroll
    for (int i = 0; i < 16; ++i) z[i] = 0.f; return z; }
__device__ __forceinline__ f32x16 mfma32(bf16x8 a, bf16x8 b, f32x16 c) { return __builtin_amdgcn_mfma_f32_32x32x16_bf16(a, b, c, 0, 0, 0); }
__device__ __forceinline__ f32x16 mma_rows(const bf16_t* A, int lda, const bf16_t* B, int ldb, int K, f32x16 acc) {
    const int lane = tidx() & 63, r = lane & 31, h = lane >> 5;
    for (int k0 = 0; k0 < K; k0 += 16) {
        bf16x8 a = *(const bf16x8*)(A + r * lda + k0 + 8 * h);
        bf16x8 b = *(const bf16x8*)(B + r * ldb + k0 + 8 * h);
        acc = mfma32(a, b, acc);
    }
    return acc;
}

namespace pg8 {
constexpr int BM = 256, BK = 64, HALF = 128, HTB = HALF * BK * 2, STAGE_BYTES = 8 * HTB, NXCD = 8, WGM = 8;
__device__ __forceinline__ int lds_byte(int r, int c) { const int st = (r >> 4) * 2 + (c >> 5), rr = r & 15, cc = c & 31, ob = rr * 64 + cc * 2; return st * 1024 + (ob ^ (((ob >> 9) & 1) << 5)); }
__device__ __forceinline__ void stage_rc(int b, int& R, int& C) { const int st = b / 1024, sb = b % 1024, swz = sb ^ (((sb >> 9) & 1) << 5); R = (st >> 1) * 16 + swz / 64; C = (st & 1) * 32 + (swz % 64) / 2; }
__device__ __forceinline__ int perm32(int rho) { const int n = rho >> 4, i = rho & 15; return 8 * (i >> 2) + 4 * n + (i & 3); }
struct Unit { int pm, pn, sp, ko; };
struct Gemm { const bf16_t* A; const bf16_t* Bt; int M, N, K, ld; };
struct Order {
    int nM, nN, nwg, G, c, ns, ksub;
    __device__ void init(int M, int N, int G_, int c_, int ns_ = 1, int ksub_ = 0) { nM = M / BM; nN = N / BM; nwg = nM * nN; G = G_; c = c_; ns = ns_; ksub = ksub_; }
    __device__ bool next(int i, Unit& u) const {
        if (c < 0) return false;
        const long L = (long)i * G + c; if (L >= (long)nwg * ns) return false;
        const int sp = (int)(L / nwg);
        int wgid = (int)(L % nwg); { const int q = nwg / NXCD, r = nwg % NXCD, xcd = wgid % NXCD, off = wgid / NXCD; wgid = (xcd < r ? xcd * (q + 1) : r * (q + 1) + (xcd - r) * q) + off; }
        const int nig = WGM * nN, gid = wgid / nig, fm = gid * WGM, gsz = (nM - fm) < WGM ? (nM - fm) : WGM;
        u.pm = fm + ((wgid % nig) % gsz); u.pn = (wgid % nig) / gsz; u.sp = sp; u.ko = sp * ksub; return true;
    }
};

template <class Epi>
__device__ __forceinline__ void gemm_phase(LAS unsigned char* lds, const Gemm g, const Order& S, const Epi& E) {
    const int tid = tidx(), wid = __builtin_amdgcn_readfirstlane(tid >> 6), lane = tid & 63, wr = wid >> 2, wc = wid & 3, fr = lane & 15, fq = lane >> 4;
    const int K = g.ld, nt = g.K / BK;
    unsigned voffA[2], voffB[2];
#pragma unroll
    for (int i = 0; i < 2; ++i) { int R, C; stage_rc(tid * 16 + i * 8192, R, C); const int Rb = Epi::PERM ? ((R & ~31) + perm32(R & 31)) : R;
        voffA[i] = (unsigned)(R * K + C) * 2u; voffB[i] = (unsigned)(Rb * K + C) * 2u; }
    const size_t kstep = (size_t)(BK * 2);
    const size_t hstep = (size_t)HALF * K * 2;
    const size_t tstep = 2 * hstep;
    const unsigned ldsw = (unsigned)wid * 1024u;
    const int aoff = lds_byte(wr * 64 + fr, fq * 8), boff = lds_byte(wc * 32 + fr, fq * 8);
#define PG8_SA(b, h) (((b) * 2 + (h)) * HTB)
#define PG8_SB(b, h) ((4 + (b) * 2 + (h)) * HTB)
#define PG8_STAGE(bufoff, gbase, voff) do { _Pragma("unroll") for (int _i = 0; _i < 2; ++_i) \
        __builtin_amdgcn_global_load_lds((const unsigned*)((const char*)(gbase) + (voff)[_i]), (LAS unsigned*)(lds + (bufoff) + ldsw + _i * 8192), 16, 0, 0); } while (0)
#define PG8_LDA(dst, b, h) do { _Pragma("unroll") for (int m = 0; m < 4; ++m) _Pragma("unroll") for (int k = 0; k < 2; ++k) dst[m][k] = *(const LAS bf16x8*)(lds + PG8_SA(b, h) + aoff + m * 2048 + k * 1024); } while (0)
#define PG8_LDB(dst, b, h) do { _Pragma("unroll") for (int n = 0; n < 2; ++n) _Pragma("unroll") for (int k = 0; k < 2; ++k) dst[n][k] = *(const LAS bf16x8*)(lds + PG8_SB(b, h) + boff + n * 2048 + k * 1024); } while (0)
#define PG8_MMA(ai, bj, At, Bt) do { __builtin_amdgcn_s_setprio(1); _Pragma("unroll") for (int m = 0; m < 4; ++m) _Pragma("unroll") for (int n = 0; n < 2; ++n) _Pragma("unroll") for (int k = 0; k < 2; ++k) \
        acc[ai][bj][m][n] = __builtin_amdgcn_mfma_f32_16x16x32_bf16(Bt[n][k], At[m][k], acc[ai][bj][m][n], 0, 0, 0); __builtin_amdgcn_s_setprio(0); } while (0)
#define PG8_WAIT_V(n) asm volatile("s_waitcnt vmcnt(" #n ")" ::: "memory")
#define PG8_WAIT_L(n) asm volatile("s_waitcnt lgkmcnt(" #n ")" ::: "memory")
#define PG8_BAR __builtin_amdgcn_s_barrier()
#define PG8_SCHED __builtin_amdgcn_sched_barrier(0)
    Unit cur, nxt; int ui = 0;
    if (!S.next(0, cur)) return;
    f32x4 acc[2][2][4][2];
#pragma unroll
    for (int a = 0; a < 2; ++a)
#pragma unroll
        for (int b = 0; b < 2; ++b)
#pragma unroll
            for (int m = 0; m < 4; ++m)
#pragma unroll
                for (int n = 0; n < 2; ++n) acc[a][b][m][n] = (f32x4){0.f, 0.f, 0.f, 0.f};
    bf16x8 At[4][2], B0[2][2], B1[2][2];
    const char* cA = (const char*)g.A + (size_t)cur.pm * tstep + (size_t)cur.ko * 2; const char* cB = (const char*)g.Bt + (size_t)cur.pn * tstep + (size_t)cur.ko * 2;
    PG8_STAGE(PG8_SB(0, 0), cB, voffB); PG8_STAGE(PG8_SA(0, 0), cA, voffA); PG8_STAGE(PG8_SB(0, 1), cB + hstep, voffB); PG8_STAGE(PG8_SA(0, 1), cA + hstep, voffA);
    if (wr == 1) PG8_BAR;
    PG8_WAIT_V(4); PG8_BAR;
    PG8_STAGE(PG8_SB(1, 0), cB + kstep, voffB); PG8_STAGE(PG8_SA(1, 0), cA + kstep, voffA); PG8_STAGE(PG8_SB(1, 1), cB + hstep + kstep, voffB);
    PG8_WAIT_V(6); PG8_BAR;
    for (;;) {
        const bool has_next = S.next(ui + 1, nxt);
        const char* nA = has_next ? (const char*)g.A + (size_t)nxt.pm * tstep + (size_t)nxt.ko * 2 : cA; const char* nB = has_next ? (const char*)g.Bt + (size_t)nxt.pn * tstep + (size_t)nxt.ko * 2 : cB;
        for (int t = 0; t < nt; t += 2) {
            const bool last = (t == nt - 2);
            const char* a1 = cA + (size_t)(t + 1) * kstep;
            const char* a2 = last ? nA : cA + (size_t)(t + 2) * kstep; const char* b2 = last ? nB : cB + (size_t)(t + 2) * kstep;
            const char* a3 = a2 + kstep; const char* b3 = b2 + kstep;
            PG8_LDB(B0, 0, 0); PG8_SCHED; PG8_LDA(At, 0, 0); PG8_STAGE(PG8_SA(1, 1), a1 + hstep, voffA);
            PG8_WAIT_L(8); PG8_BAR; PG8_WAIT_L(0); PG8_MMA(0, 0, At, B0); PG8_BAR; PG8_SCHED;
            PG8_LDB(B1, 0, 1); PG8_STAGE(PG8_SB(0, 0), b2, voffB);
            PG8_BAR; PG8_WAIT_L(0); PG8_MMA(0, 1, At, B1); PG8_BAR;
            PG8_LDA(At, 0, 1); PG8_STAGE(PG8_SA(0, 0), a2, voffA);
            PG8_BAR; PG8_WAIT_L(0); PG8_MMA(1, 0, At, B0); PG8_BAR; PG8_SCHED;
            PG8_STAGE(PG8_SB(0, 1), b2 + hstep, voffB);
            PG8_WAIT_V(6); PG8_BAR; PG8_MMA(1, 1, At, B1); PG8_BAR;
            PG8_LDB(B0, 1, 0); PG8_SCHED; PG8_LDA(At, 1, 0); PG8_STAGE(PG8_SA(0, 1), a2 + hstep, voffA);
            PG8_WAIT_L(8); PG8_BAR; PG8_WAIT_L(0); PG8_MMA(0, 0, At, B0); PG8_BAR; PG8_SCHED;
            PG8_LDB(B1, 1, 1); PG8_STAGE(PG8_SB(1, 0), b3, voffB);
            PG8_BAR; PG8_WAIT_L(0); PG8_MMA(0, 1, At, B1); PG8_BAR;
            PG8_LDA(At, 1, 1); PG8_STAGE(PG8_SA(1, 0), a3, voffA);
            PG8_BAR; PG8_WAIT_L(0); PG8_MMA(1, 0, At, B0); PG8_BAR; PG8_SCHED;
            PG8_STAGE(PG8_SB(1, 1), b3 + hstep, voffB);
            PG8_WAIT_V(6); PG8_BAR; PG8_MMA(1, 1, At, B1); PG8_BAR;
        }
        E(acc, cur, wr, wc, fr, fq);
        if (!has_next) break;
#pragma unroll
        for (int a = 0; a < 2; ++a)
#pragma unroll
            for (int b = 0; b < 2; ++b)
#pragma unroll
                for (int m = 0; m < 4; ++m)
#pragma unroll
                    for (int n = 0; n < 2; ++n) acc[a][b][m][n] = (f32x4){0.f, 0.f, 0.f, 0.f};
        cur = nxt; cA = nA; cB = nB; ++ui;
    }
    PG8_WAIT_V(0);
    if (wr == 0) PG8_BAR;
    PG8_BAR;
#undef PG8_SA
#undef PG8_SB
#undef PG8_STAGE
#undef PG8_LDA
#undef PG8_LDB
#undef PG8_MMA
#undef PG8_WAIT_V
#undef PG8_WAIT_L
#undef PG8_BAR
#undef PG8_SCHED
}
struct EpiStore {
    static constexpr bool PERM = true;
    bf16_t* O; int ldc; int ncols; size_t split_stride;
    __device__ __forceinline__ void operator()(const f32x4 (&acc)[2][2][4][2], const Unit& u, int wr, int wc, int fr, int fq) const {
        const int row0 = u.pm * BM + wr * 64 + fr, col0 = u.pn * BM + wc * 32 + 8 * fq;
#pragma unroll
        for (int ai = 0; ai < 2; ++ai)
#pragma unroll
            for (int m = 0; m < 4; ++m) { bf16_t* rowp = O + (size_t)u.sp * split_stride + (size_t)(row0 + ai * HALF + m * 16) * ldc;
#pragma unroll
                for (int bj = 0; bj < 2; ++bj) { const int col = col0 + bj * HALF; if (col < ncols) {
                    const f32x4 v0 = acc[ai][bj][m][0], v1 = acc[ai][bj][m][1];
                    u32x4 o; o[0] = pk2(v0[0], v0[1]); o[1] = pk2(v0[2], v0[3]); o[2] = pk2(v1[0], v1[1]); o[3] = pk2(v1[2], v1[3]);
                    *(u32x4*)(rowp + col) = o; } } }
    }
};
struct EpiSwiglu {
    static constexpr bool PERM = true;
    bf16_t* O;
    __device__ __forceinline__ void operator()(const f32x4 (&acc)[2][2][4][2], const Unit& u, int wr, int wc, int fr, int fq) const {
        const int row0 = u.pm * BM + wr * 64 + fr, col0 = u.pn * 128 + wc * 32 + 8 * fq;
#pragma unroll
        for (int ai = 0; ai < 2; ++ai)
#pragma unroll
            for (int m = 0; m < 4; ++m) { bf16_t* rowp = O + (size_t)(row0 + ai * HALF + m * 16) * 2816 + col0;
                float r[8];
#pragma unroll
                for (int n = 0; n < 2; ++n)
#pragma unroll
                    for (int q = 0; q < 4; ++q) r[n * 4 + q] = silu_f(acc[ai][0][m][n][q]) * acc[ai][1][m][n][q];
                u32x4 o; o[0] = pk2(r[0], r[1]); o[1] = pk2(r[2], r[3]); o[2] = pk2(r[4], r[5]); o[3] = pk2(r[6], r[7]);
                *(u32x4*)rowp = o; }
    }
};
}

struct Job { const float* src; int ld, Ks, mode; bf16_t* dst; int Nd, Kd; };
__device__ __forceinline__ int job_srccol(int mode, int n0) {
    switch (mode) {
        case 0: return n0;
        case 1: return n0 < 1536 ? n0 : n0 + 32;
        case 2: return 1536;
        case 3: return n0 < 1984 ? n0 : -1;
        case 4: return (n0 >> 7) * 256 + (n0 & 127);
        case 5: return (n0 >> 7) * 256 + 128 + (n0 & 127);
        default: { const int pn = n0 >> 8, x0 = n0 & 255; return x0 < 128 ? pn * 128 + x0 : 2816 + pn * 128 + x0 - 128; }
    }
}
__device__ __forceinline__ Job get_job(PRef p, int idx) {
    Job j; unsigned char* ws = p.ws;
    if (idx < 2)       { const int i = idx;      j = {p.in[12] + (size_t)i * 1024 * 2592, 2592, 1024, 1, (bf16_t*)(ws + WS_WINE) + (size_t)i * 2560 * 1024, 2560, 1024}; }
    else if (idx < 4)  { const int i = idx - 2;  j = {p.in[12] + (size_t)i * 1024 * 2592, 2592, 1024, 2, (bf16_t*)(ws + WS_WZ) + (size_t)i * 32 * 1024, 32, 1024}; }
    else if (idx < 6)  { const int i = idx - 4;  j = {p.in[20] + (size_t)i * 1024 * 1024, 1024, 1024, 0, (bf16_t*)(ws + WS_WOUTE) + (size_t)i * 1024 * 1024, 1024, 1024}; }
    else if (idx < 8)  { const int i = idx - 6;  j = {p.in[21] + (size_t)i * 1024 * 1984, 1984, 1024, 3, (bf16_t*)(ws + WS_WINO) + (size_t)i * 2048 * 1024, 2048, 1024}; }
    else if (idx < 10) { const int i = idx - 8;  j = {p.in[35] + (size_t)i * 1024 * 1024, 1024, 1024, 0, (bf16_t*)(ws + WS_WOUTO) + (size_t)i * 1024 * 1024, 1024, 1024}; }
    else if (idx < 12) { const int i = idx - 10; j = {p.in[32] + (size_t)i * 256 * 768, 768, 256, 0, (bf16_t*)(ws + WS_WQB) + (size_t)i * 768 * 256, 768, 256}; }
    else if (idx < 14) { const int i = idx - 12; j = {p.in[34] + (size_t)i * 128 * 1024, 1024, 128, 4, (bf16_t*)(ws + WS_WKVK) + (size_t)i * 512 * 256, 512, 256}; }
    else if (idx < 16) { const int i = idx - 14; j = {p.in[34] + (size_t)i * 128 * 1024, 1024, 128, 5, (bf16_t*)(ws + WS_WKVV) + (size_t)i * 512 * 256, 512, 256}; }
    else if (idx < 20) { const int i = idx - 16; j = {p.in[36] + (size_t)i * 1024 * 5632, 5632, 1024, 6, (bf16_t*)(ws + WS_WFI) + (size_t)i * 5632 * 1024, 5632, 1024}; }
    else               { const int i = idx - 20; j = {p.in[37] + (size_t)i * 2816 * 1024, 1024, 2816, 0, (bf16_t*)(ws + WS_WFO) + (size_t)i * 1024 * 2816, 1024, 2816}; }
    return j;
}
constexpr int N_JOBS = 24;

__device__ __forceinline__ void conv_tile(const Job& jb, int tile, float* tl) {
    const int nkt = jb.Kd >> 8; const int nti = tile / nkt, kt = tile % nkt; const int n0 = nti * 64, k0 = kt * 256;
    const int sc = job_srccol(jb.mode, n0);
    const int t = tidx();
    if (sc >= 0) {
        f32x4 v[8];
#pragma unroll
        for (int q = 0; q < 8; ++q) { const int idx = t + 512 * q, k = idx >> 4, c4 = idx & 15;
            v[q] = (k0 + k < jb.Ks) ? *(const f32x4*)(jb.src + (size_t)(k0 + k) * jb.ld + sc + c4 * 4) : (f32x4){0.f, 0.f, 0.f, 0.f}; }
#pragma unroll
        for (int q = 0; q < 8; ++q) { const int idx = t + 512 * q, k = idx >> 4, c4 = idx & 15; float* d = tl + k * 65 + c4 * 4; d[0] = v[q][0]; d[1] = v[q][1]; d[2] = v[q][2]; d[3] = v[q][3]; } }
    __syncthreads();
    { const int kq = t & 7, n = t >> 3;
      if (n0 + n < jb.Nd) {
#pragma unroll
          for (int m = 0; m < 4; ++m) { const int kc = kq + 8 * m; float v[8];
#pragma unroll
              for (int i = 0; i < 8; ++i) v[i] = sc < 0 ? 0.f : tl[(kc * 8 + i) * 65 + n];
              u32x4 o; o[0] = pk2(v[0], v[1]); o[1] = pk2(v[2], v[3]); o[2] = pk2(v[4], v[5]); o[3] = pk2(v[6], v[7]);
              *(u32x4*)(jb.dst + (size_t)(n0 + n) * jb.Kd + k0 + kc * 8) = o; } } }
    __syncthreads();
}

__device__ __forceinline__ int layer_job(int l, int k) {
    const int j = l >> 1;
    if ((l & 1) == 0) { switch (k) { case 0: return j; case 1: return 2 + j; case 2: return 4 + j; case 3: return 16 + l; case 4: return 20 + l; default: return -1; } }
    switch (k) { case 0: return 6 + j; case 1: return 8 + j; case 2: return 10 + j; case 3: return 12 + j; case 4: return 14 + j; case 5: return 16 + l; case 6: return 20 + l; default: return -1; }
}
__device__ __forceinline__ void conv_layer(PRef p, int l, int wi, int nw, float* tl, int which = 0  ) {
    int tbase = 0;
    for (int k = 0; k < 7; ++k) { const int ji = layer_job(l, k); if (ji < 0) break;
        const bool is_fo = ji >= 20; if ((which == 1 && is_fo) || (which == 2 && !is_fo)) continue;
        const Job jb = get_job(p, ji); const int ntile = ((jb.Nd + 63) >> 6) * (jb.Kd >> 8);
        const int first = (wi - (tbase % nw) + nw) % nw;
        for (int tile = first; tile < ntile; tile += nw) conv_tile(jb, tile, tl);
        tbase += ntile; }
}

__device__ __forceinline__ void phase_prep(PRef p, unsigned char* shm) {
    const int t = tidx(), wg = bidx(), nwg = gdim();
    unsigned char* ws = p.ws;
    { float* X = (float*)(ws + WS_X); const f32x4* xp = (const f32x4*)p.in[0]; const f32x4* xs = (const f32x4*)p.in[1]; f32x4* X4 = (f32x4*)X;
      const size_t n4 = (size_t)T * 256, np4 = (size_t)4096 * 256;
      for (size_t i = (size_t)wg * 512 + t; i < n4; i += (size_t)nwg * 512) X4[i] = i < np4 ? xp[i] : xs[i - np4];
      bf16_t* CKV = (bf16_t*)(ws + WS_CKV); bf16_t* KPE = (bf16_t*)(ws + WS_KPE);
      for (size_t i = (size_t)wg * 512 + t; i < (size_t)2 * TK * 256; i += (size_t)nwg * 512) {
          const int j = (int)(i / ((size_t)TK * 256)); const int rem = (int)(i % ((size_t)TK * 256)); const int r = rem >> 8, c = rem & 255;
          if (c >= 128) CKV[i] = 0;
          else if (r >= T) { const int b = (r - T) >> 9, pp = (r - T) & 511; CKV[i] = f2bf(p.in[6][((size_t)(b * 2 + j) * 512 + pp) * 128 + c]); } }
      for (size_t i = (size_t)wg * 512 + t; i < (size_t)2 * 1024 * 64; i += (size_t)nwg * 512) {
          const int j = (int)(i >> 16); const int rem = (int)(i & 65535); const int rr = rem >> 6, c = rem & 63; const int b = rr >> 9, pp = rr & 511;
          KPE[((size_t)j * TK + T + rr) * 64 + c] = f2bf(p.in[7][((size_t)(b * 2 + j) * 512 + pp) * 64 + c]); } }
    float* sc = (float*)(shm + 81920);
    float* red = sc + 3072;
    {
      for (int i = t; i < 3072; i += 512) { const int ci = i >> 10, k = i & 1023; const float v = ci == 0 ? p.in[9][k] : p.in[8][(ci - 1) * 1024 + k]; sc[i] = silu_f(v); }
      __syncthreads();
      }
    auto adaln_task = [&](int task) {
          float* MOD = (float*)(ws + WS_MOD);
          const int l = task / 96, cb = task % 96; const int col = t & 63, kg = t >> 6;
          const float* w = p.in[10] + (size_t)l * 1024 * 6144 + cb * 64 + col;
          float a0 = 0.f, a1 = 0.f, a2 = 0.f;
#pragma unroll 8
          for (int k = kg * 128; k < kg * 128 + 128; ++k) { const float wv = w[(size_t)k * 6144]; a0 += sc[k] * wv; a1 += sc[1024 + k] * wv; a2 += sc[2048 + k] * wv; }
          red[(kg * 3 + 0) * 64 + col] = a0; red[(kg * 3 + 1) * 64 + col] = a1; red[(kg * 3 + 2) * 64 + col] = a2;
          __syncthreads();
          if (t < 192) { const int ci = t >> 6, c2 = t & 63; float s = p.in[11][(size_t)l * 6144 + cb * 64 + c2];
#pragma unroll
              for (int g = 0; g < 8; ++g) s += red[(g * 3 + ci) * 64 + c2];
              MOD[((size_t)l * 3 + ci) * 6144 + cb * 64 + c2] = s; }
          __syncthreads();
      };
    float* zf = (float*)shm;
    float* h1 = zf + 320;
    float* h2 = h1 + 512;
    bf16_t* GR = (bf16_t*)(ws + WS_GR);
    auto filter_task = [&](int task) {
          const int j = task / 160, tb = task % 160; const int type = tb < 32 ? 0 : 1; const int L = type ? 1024 : 256; const int pos0 = (type ? tb - 32 : tb) * 8;
          if (t < 8 * 33) { const int pi = t / 33, e = t % 33; const int idx = pos0 + pi; float v;
              if (e == 0) v = (float)idx / (float)(L - 1);
              else { const int b = (e - 1) & 15; const float f = 1e-4f + (float)b * ((15.0f - 1e-4f) / 15.0f); const float w = 6.283185307179586f * (float)idx / (float)L; v = e <= 16 ? __cosf(f * w) : -__sinf(f * w); }
              zf[pi * 40 + e] = v; }
          __syncthreads();
          { const int pi = t >> 6, u = t & 63; float s = p.in[26][j * 64 + u]; const float* w1 = p.in[25] + (size_t)j * 33 * 64 + u;
            for (int e = 0; e < 33; ++e) s += zf[pi * 40 + e] * w1[e * 64];
            h1[pi * 64 + u] = __sinf(p.in[27][j * 64 + u] * s); }
          __syncthreads();
          { const int pi = t >> 6, u = t & 63; float s = p.in[29][j * 64 + u]; const float* w2 = p.in[28] + (size_t)j * 64 * 64 + u;
            for (int e = 0; e < 64; ++e) s += h1[pi * 64 + e] * w2[e * 64];
            h2[pi * 64 + u] = __sinf(p.in[27][j * 64 + u] * s); }
          __syncthreads();
          { const float* w3 = p.in[30] + (size_t)j * 64 * 1024;
            bf16_t* gr = GR + (size_t)j * 512 * 2560 + (type ? (size_t)512 * 512 : 0);
            for (int cc = 0; cc < 2; ++cc) { const int col = t + cc * 512; float a[8];
#pragma unroll
                for (int q = 0; q < 8; ++q) a[q] = 0.f;
                for (int e = 0; e < 64; ++e) { const float wv = w3[e * 1024 + col];
#pragma unroll
                    for (int q = 0; q < 8; ++q) a[q] += h2[q * 64 + e] * wv; }
                const int ch = col & 511; const float delta = fabsf(-3.0701134573253945f + (float)ch * ((-15.350567286626973f + 3.0701134573253945f) / 511.0f));
                bf16_t* grc = gr + (size_t)ch * (2 * L);
#pragma unroll
                for (int q = 0; q < 8; ++q) { const int idx = pos0 + q; const float tp = (float)idx / (float)(L - 1); const float v = a[q] * __expf(-tp * delta);
                    if (col < 512) grc[L - 1 - idx] = f2bf(v);
                    else if (idx >= 1) grc[L - 1 + idx] = f2bf(v);
                    else grc[2 * L - 1] = 0; } } }
          __syncthreads();
      };
    { int jstart[8]; int total = 0;
#pragma unroll
      for (int k = 0; k < 7; ++k) { const int ji = layer_job(0, k); jstart[k] = total; if (ji >= 0) { const Job jb = get_job(p, ji); total += ((jb.Nd + 63) >> 6) * (jb.Kd >> 8); } }
      unsigned* q = (unsigned*)(ws + WS_BAR) + 15; volatile unsigned* slot = (volatile unsigned*)(shm + (LDS_BYTES - 32));
      for (;;) {
          if (threadIdx.x == 0) *slot = __hip_atomic_fetch_add(q, 1u, __ATOMIC_RELAXED, __HIP_MEMORY_SCOPE_AGENT);
          __syncthreads();
          const int it = (int)*slot;
          __syncthreads();
          if (it >= 704 + total) break;
          if (it < 320) filter_task(it);
          else if (it < 704) adaln_task(it - 320);
          else { const int idx = it - 704; int k = 0, base = 0;
#pragma unroll
              for (int z = 1; z < 7; ++z) if (idx >= jstart[z]) { k = z; base = jstart[z]; }
              const Job jb = get_job(p, layer_job(0, k)); conv_tile(jb, idx - base, (float*)shm); }
      } }
}

__device__ __forceinline__ void phase_norm(PRef p, int l, int which  ) {
    const int lane = tidx() & 63, wv = tidx() >> 6;
    float* X = (float*)(p.ws + WS_X); bf16_t* H = (bf16_t*)(p.ws + WS_H); const float* MOD = (const float*)(p.ws + WS_MOD); const bf16_t* P = (const bf16_t*)(p.ws + WS_P);
    const bool add = !(which == 0 && l == 0);
    const int gl = which == 1 ? l : (which == 2 ? 3 : l - 1); const int goff = which == 1 ? 2048 : 5120;
    const int stride = gdim() * 8;
    for (int rowb = bidx() * 8 + wv; rowb < T; rowb += 2 * stride) {
        f32x4 v[2][4]; float rstd[2];
#pragma unroll
        for (int u = 0; u < 2; ++u) { const int row = rowb + u * stride; if (row < T) {
            if (!add) { const f32x4* xi = (const f32x4*)(row < 4096 ? p.in[0] + (size_t)row * 1024 : p.in[1] + (size_t)(row - 4096) * 1024);
#pragma unroll
                for (int i = 0; i < 4; ++i) v[u][i] = xi[lane + 64 * i]; }
            else { const f32x4* xr = (const f32x4*)(X + (size_t)row * 1024);
#pragma unroll
                for (int i = 0; i < 4; ++i) v[u][i] = xr[lane + 64 * i]; } } }
        if (add) {
            f32x4 g[2][4]; u32x2 pa[2][4], pb[2][4];
#pragma unroll
            for (int u = 0; u < 2; ++u) { const int row = rowb + u * stride; if (row < T) { const float* gp = MOD + ((size_t)gl * 3 + cvec_of(row)) * 6144 + goff;
#pragma unroll
                for (int i = 0; i < 4; ++i) { g[u][i] = ((const f32x4*)gp)[lane + 64 * i];
                    pa[u][i] = *(const u32x2*)(P + (size_t)row * 1024 + (lane + 64 * i) * 4); pb[u][i] = *(const u32x2*)(P + (size_t)T * 1024 + (size_t)row * 1024 + (lane + 64 * i) * 4); } } }
#pragma unroll
            for (int u = 0; u < 2; ++u) { const int row = rowb + u * stride; if (row < T) {
#pragma unroll
                for (int i = 0; i < 4; ++i) { const u32x2 a = pa[u][i], b = pb[u][i]; f32x4 s4;
                    s4[0] = __uint_as_float(a[0] << 16) + __uint_as_float(b[0] << 16); s4[1] = __uint_as_float(a[0] & 0xFFFF0000u) + __uint_as_float(b[0] & 0xFFFF0000u);
                    s4[2] = __uint_as_float(a[1] << 16) + __uint_as_float(b[1] << 16); s4[3] = __uint_as_float(a[1] & 0xFFFF0000u) + __uint_as_float(b[1] & 0xFFFF0000u);
                    v[u][i] += g[u][i] * s4; } } }
        }
        f32x4 sh[2][4], sc[2][4];
#pragma unroll
        for (int u = 0; u < 2; ++u) { const int row = rowb + u * stride; if (row < T) {
            if (which == 2) {
#pragma unroll
                for (int i = 0; i < 4; ++i) sc[u][i] = ((const f32x4*)p.in[38])[lane + 64 * i]; }
            else { const float* m = MOD + ((size_t)l * 3 + cvec_of(row)) * 6144 + which * 3072;
#pragma unroll
                for (int i = 0; i < 4; ++i) { sh[u][i] = ((const f32x4*)m)[lane + 64 * i]; sc[u][i] = ((const f32x4*)(m + 1024))[lane + 64 * i]; } } } }
#pragma unroll
        for (int u = 0; u < 2; ++u) { const int row = rowb + u * stride; if (row < T) { float ss = 0.f;
#pragma unroll
            for (int i = 0; i < 4; ++i) ss += v[u][i][0] * v[u][i][0] + v[u][i][1] * v[u][i][1] + v[u][i][2] * v[u][i][2] + v[u][i][3] * v[u][i][3];
            ss = wave_sum(ss); rstd[u] = rsqrtf(ss * (1.0f / 1024.0f) + EPS); } }
#pragma unroll
        for (int u = 0; u < 2; ++u) { const int row = rowb + u * stride; if (row < T) {
            if (which != 2 || true) { if (which != 2) { f32x4* xr = (f32x4*)(X + (size_t)row * 1024);
#pragma unroll
                for (int i = 0; i < 4; ++i) xr[lane + 64 * i] = v[u][i]; } }
            if (which == 2) { float* o = p.out + (row < 4096 ? O_YP + (size_t)row * 1024 : O_YS + (size_t)(row - 4096) * 1024);
#pragma unroll
                for (int i = 0; i < 4; ++i) ((f32x4*)o)[lane + 64 * i] = v[u][i] * rstd[u] * sc[u][i]; }
            else {
#pragma unroll
                for (int i = 0; i < 4; ++i) { const f32x4 hv = v[u][i] * rstd[u] * (sc[u][i] + 1.0f) + sh[u][i]; u32x2 o; o[0] = pk2(hv[0], hv[1]); o[1] = pk2(hv[2], hv[3]);
                    *(u32x2*)(H + (size_t)row * 1024 + (lane + 64 * i) * 4) = o; } } } }
    }
}

__device__ __forceinline__ void phase_zgemm(PRef p, int j, unsigned char* shm) {
    const int t = tidx(), lane = t & 63, wv = t >> 6, r = lane & 31, h = lane >> 5;
    const bf16_t* H = (const bf16_t*)(p.ws + WS_H); const bf16_t* WZ = (const bf16_t*)(p.ws + WS_WZ) + (size_t)j * 32 * 1024; float* ZG = (float*)(p.ws + WS_ZG);
    float* red = (float*)shm;
    for (int tile = bidx(); tile < T / 32; tile += gdim()) {
        f32x16 acc = zero16();
        const bf16_t* a = H + (size_t)(tile * 32 + r) * 1024 + wv * 128 + 8 * h; const bf16_t* b = WZ + (size_t)r * 1024 + wv * 128 + 8 * h;
        bf16x8 av[8], bv[8];
#pragma unroll
        for (int ks = 0; ks < 8; ++ks) { av[ks] = *(const bf16x8*)(a + ks * 16); bv[ks] = *(const bf16x8*)(b + ks * 16); }
#pragma unroll
        for (int ks = 0; ks < 8; ++ks) acc = mfma32(av[ks], bv[ks], acc);
#pragma unroll
        for (int q = 0; q < 16; ++q) red[(wv * 16 + q) * 64 + lane] = acc[q];
        __syncthreads();
        for (int e = t; e < 1024; e += 512) { const int q = e >> 6, ln = e & 63; float s2 = 0.f;
#pragma unroll
            for (int w = 0; w < 8; ++w) s2 += red[(w * 16 + q) * 64 + ln];
            const int row = tile * 32 + (q & 3) + 8 * (q >> 2) + 4 * (ln >> 5); ZG[(size_t)row * 32 + (ln & 31)] = s2; }
        __syncthreads();
    }
}

__device__ __forceinline__ int seq_base(int s) { return s < 16 ? s * 256 : 4096 + (s - 16) * 1024; }
__device__ __forceinline__ int gla_item(int s, int h, int c, int dir) { return s < 16 ? ((s * 4 + h) * 4 + c) * 2 + dir : 512 + (((s - 16) * 4 + h) * 16 + c) * 2 + dir; }
constexpr int GLD = 72;

__device__ __forceinline__ void gla_gates(PRef p, int j, int h, int dir, int tok0, float* ZL, float* PT, float (&b)[8], float& blast) {
    const int t = tidx(), d = t & 63, g8 = t >> 6;
    const float* ZG = (const float*)(p.ws + WS_ZG);
    for (int e = t; e < 1024; e += 512) { const int ip = e >> 4, jz = e & 15; const int tok = tok0 + (dir ? 63 - ip : ip); ZL[e] = ZG[(size_t)tok * 32 + dir * 16 + jz]; }
    __syncthreads();
    const float* wg_ = p.in[dir ? 15 : 13] + (size_t)j * 16 * 256 + h * 64 + d;
    float w[16];
#pragma unroll
    for (int q = 0; q < 16; ++q) w[q] = wg_[q * 256];
    const float bias = p.in[dir ? 16 : 14][j * 256 + h * 64 + d];
    float run = 0.f;
#pragma unroll
    for (int ii = 0; ii < 8; ++ii) { const int ip = g8 * 8 + ii; float x = bias;
#pragma unroll
        for (int q = 0; q < 16; ++q) x += ZL[ip * 16 + q] * w[q];
        const float ls = fminf(x, 0.f) - log1pf(__expf(-fabsf(x)));
        run += ls * (1.0f / 16.0f); b[ii] = run; }
    PT[g8 * 64 + d] = run;
    __syncthreads();
    float off = 0.f, tot = 0.f;
#pragma unroll
    for (int g = 0; g < 8; ++g) { const float v = PT[g * 64 + d]; tot += v; if (g < g8) off += v; }
#pragma unroll
    for (int ii = 0; ii < 8; ++ii) b[ii] += off;
    blast = tot;
    __syncthreads();
}
__device__ __forceinline__ void gla_load_vt(const bf16_t* PROJ, int h, int dir, int tok0, bf16_t* VTL) {
    const int t = tidx(), e = t & 127, grp = t >> 7;
    unsigned pk[8];
#pragma unroll
    for (int q = 0; q < 8; ++q) { const int i0 = grp * 16 + 2 * q; const int tk0 = tok0 + (dir ? 63 - i0 : i0), tk1 = tok0 + (dir ? 62 - i0 : i0 + 1);
        const unsigned lo = PROJ[(size_t)tk0 * 2560 + 512 + h * 128 + e], hi = PROJ[(size_t)tk1 * 2560 + 512 + h * 128 + e]; pk[q] = lo | (hi << 16); }
    u32x4 o0, o1; o0[0] = pk[0]; o0[1] = pk[1]; o0[2] = pk[2]; o0[3] = pk[3]; o1[0] = pk[4]; o1[1] = pk[5]; o1[2] = pk[6]; o1[3] = pk[7];
    *(u32x4*)(VTL + e * GLD + grp * 16) = o0; *(u32x4*)(VTL + e * GLD + grp * 16 + 8) = o1;
}

__device__ __forceinline__ void gla_pass_a(PRef p, int j, int item, unsigned char* shm) {
    int s, h, c, dir;
    if (item < 512) { s = item >> 5; const int rem = item & 31; h = rem >> 3; c = (rem & 7) >> 1; dir = rem & 1; }
    else { const int it = item - 512; s = 16 + (it >> 7); const int rem = it & 127; h = rem >> 5; c = (rem & 31) >> 1; dir = rem & 1; }
    const int tok0 = seq_base(s) + 64 * c;
    bf16_t* KTL = (bf16_t*)shm;
    bf16_t* VTL = KTL + 64 * GLD;
    float* ZL = (float*)(VTL + 128 * GLD);
    float* PT = ZL + 1024;
    const bf16_t* PROJ = (const bf16_t*)(p.ws + WS_PROJ);
    float* DS = (float*)(p.ws + WS_DS) + (size_t)item * 8192; float* DEC = (float*)(p.ws + WS_DEC) + (size_t)item * 64;
    const int t = tidx(), d = t & 63, g8 = t >> 6;
    bf16_t kr[8];
#pragma unroll
    for (int ii = 0; ii < 8; ++ii) { const int ip = g8 * 8 + ii; const int tok = tok0 + (dir ? 63 - ip : ip); kr[ii] = PROJ[(size_t)tok * 2560 + 256 + h * 64 + d]; }
    gla_load_vt(PROJ, h, dir, tok0, VTL);
    float b[8], blast;
    gla_gates(p, j, h, dir, tok0, ZL, PT, b, blast);
    { unsigned pk[4];
#pragma unroll
      for (int q = 0; q < 4; ++q) pk[q] = pk2(bf2f(kr[2 * q]) * __expf(blast - b[2 * q]), bf2f(kr[2 * q + 1]) * __expf(blast - b[2 * q + 1]));
      u32x4 o; o[0] = pk[0]; o[1] = pk[1]; o[2] = pk[2]; o[3] = pk[3];
      *(u32x4*)(KTL + d * GLD + g8 * 8) = o; }
    if (t < 64) DEC[t] = __expf(blast);
    __syncthreads();
    { const int wv = t >> 6, lane = t & 63, mt = wv >> 2, nt = wv & 3, hh = lane >> 5, r = lane & 31;
      f32x16 acc = mma_rows(KTL + mt * 32 * GLD, GLD, VTL + nt * 32 * GLD, GLD, 64, zero16());
#pragma unroll
      for (int q = 0; q < 16; ++q) { const int dd = 32 * mt + (q & 3) + 8 * (q >> 2) + 4 * hh; DS[dd * 128 + 32 * nt + r] = acc[q]; } }
    __syncthreads();
}

__device__ __forceinline__ void gla_pass_b(PRef p, int j, int item, unsigned char* shm) {
    int s, h, c, nC;
    if (item < 256) { s = item >> 4; h = (item >> 2) & 3; c = item & 3; nC = 4; }
    else { const int it = item - 256; s = 16 + (it >> 6); h = (it >> 4) & 3; c = it & 15; nC = 16; }
    const int tok0 = seq_base(s) + 64 * c;
    float* OL = (float*)shm;
    bf16_t* QL = (bf16_t*)(OL + 64 * 132);
    bf16_t* KL = QL + 64 * GLD;
    bf16_t* PL = KL + 64 * GLD;
    bf16_t* VTL = PL + 64 * GLD;
    bf16_t* STL = VTL + 128 * GLD;
    float* ZL = (float*)(STL + 128 * GLD);
    float* PT = ZL + 1024;
    const bf16_t* PROJ = (const bf16_t*)(p.ws + WS_PROJ);
    const float* DSb = (const float*)(p.ws + WS_DS); const float* DECb = (const float*)(p.ws + WS_DEC);
    const int t = tidx(), d = t & 63, g8 = t >> 6, wv = t >> 6, lane = t & 63;
    bf16_t ra0[8], ra1[8];
#pragma unroll
    for (int q = 0; q < 8; ++q) { const int tok = tok0 + wv * 8 + q; ra0[q] = PROJ[(size_t)tok * 2560 + 1024 + h * 128 + lane]; ra1[q] = PROJ[(size_t)tok * 2560 + 1024 + h * 128 + 64 + lane]; }
    for (int dir = 0; dir < 2; ++dir) {
        bf16_t qr[8], kr[8];
#pragma unroll
        for (int ii = 0; ii < 8; ++ii) { const int ip = g8 * 8 + ii; const int tok = tok0 + (dir ? 63 - ip : ip);
            qr[ii] = PROJ[(size_t)tok * 2560 + h * 64 + d]; kr[ii] = PROJ[(size_t)tok * 2560 + 256 + h * 64 + d]; }
        gla_load_vt(PROJ, h, dir, tok0, VTL);
        { const int e = t & 127, dg = t >> 7; float S[16];
          if (s >= 16) { const float* st = p.in[dir ? 3 : 2] + ((size_t)((s - 16) * 2 + j) * 4 + h) * 8192;
#pragma unroll
              for (int i = 0; i < 16; ++i) S[i] = st[(dg * 16 + i) * 128 + e]; }
          else {
#pragma unroll
              for (int i = 0; i < 16; ++i) S[i] = 0.f; }
          const int nprev = dir ? nC - 1 - c : c;
#pragma unroll 2
          for (int q = 0; q < nprev; ++q) { const int cc = dir ? nC - 1 - q : q; const int it = gla_item(s, h, cc, dir);
              const float* ds = DSb + (size_t)it * 8192 + (size_t)(dg * 16) * 128 + e; const f32x4* dc4 = (const f32x4*)(DECb + (size_t)it * 64 + dg * 16);
              float dv[16]; f32x4 dcv[4];
#pragma unroll
              for (int i = 0; i < 4; ++i) dcv[i] = dc4[i];
#pragma unroll
              for (int i = 0; i < 16; ++i) dv[i] = ds[i * 128];
#pragma unroll
              for (int i = 0; i < 16; ++i) S[i] = S[i] * dcv[i >> 2][i & 3] + dv[i]; }
          u32x4 o0, o1;
          o0[0] = pk2(S[0], S[1]); o0[1] = pk2(S[2], S[3]); o0[2] = pk2(S[4], S[5]); o0[3] = pk2(S[6], S[7]);
          o1[0] = pk2(S[8], S[9]); o1[1] = pk2(S[10], S[11]); o1[2] = pk2(S[12], S[13]); o1[3] = pk2(S[14], S[15]);
          *(u32x4*)(STL + e * GLD + dg * 16) = o0; *(u32x4*)(STL + e * GLD + dg * 16 + 8) = o1;
          if (s < 16 && ((dir == 0 && c == nC - 1) || (dir == 1 && c == 0))) {
              const int it = gla_item(s, h, c, dir); const float* ds = DSb + (size_t)it * 8192; const float* dc = DECb + (size_t)it * 64;
              float* o = p.out + (dir ? O_SB : O_SF) + ((size_t)(s * 2 + j) * 4 + h) * 8192;
#pragma unroll
              for (int i = 0; i < 16; ++i) o[(dg * 16 + i) * 128 + e] = S[i] * dc[dg * 16 + i] + ds[(dg * 16 + i) * 128 + e]; } }
        float b[8], blast;
        gla_gates(p, j, h, dir, tok0, ZL, PT, b, blast);
#pragma unroll
        for (int ii = 0; ii < 8; ++ii) { const int ip = g8 * 8 + ii;
            const float qv = bf2f(qr[ii]) * 0.125f * __expf(b[ii]);
            const float kv = bf2f(kr[ii]) * __expf(-b[ii]);
            QL[ip * GLD + d] = f2bf(qv); KL[ip * GLD + d] = f2bf(kv); }
        __syncthreads();
        const int hh = lane >> 5, r = lane & 31;
        if (wv < 4) { const int mt = wv >> 1, nt = wv & 1;
            f32x16 sc = mma_rows(QL + mt * 32 * GLD, GLD, KL + nt * 32 * GLD, GLD, 64, zero16());
#pragma unroll
            for (int q = 0; q < 16; ++q) { const int ip = 32 * mt + (q & 3) + 8 * (q >> 2) + 4 * hh, jp = 32 * nt + r; PL[ip * GLD + jp] = f2bf(jp <= ip ? sc[q] : 0.f); } }
        const int mt = wv >> 2, nt = wv & 3;
        f32x16 acc = mma_rows(QL + mt * 32 * GLD, GLD, STL + nt * 32 * GLD, GLD, 64, zero16());
        __syncthreads();
        acc = mma_rows(PL + mt * 32 * GLD, GLD, VTL + nt * 32 * GLD, GLD, 64, acc);
#pragma unroll
        for (int q = 0; q < 16; ++q) { const int ip = 32 * mt + (q & 3) + 8 * (q >> 2) + 4 * hh; const int pp = dir ? 63 - ip : ip; float* o = OL + pp * 132 + 32 * nt + r;
            if (dir == 0) *o = acc[q]; else *o += acc[q]; }
        __syncthreads();
    }
    bf16_t* MIX = (bf16_t*)(p.ws + WS_MIX);
    const float g0 = p.in[17][j * 128 + lane], g1 = p.in[17][j * 128 + 64 + lane];
#pragma unroll
    for (int q = 0; q < 8; ++q) { const int pp = wv * 8 + q; const int tok = tok0 + pp;
        const float v0 = OL[pp * 132 + lane], v1 = OL[pp * 132 + 64 + lane];
        const float ss = wave_sum(v0 * v0 + v1 * v1); const float rstd = rsqrtf(ss * (1.0f / 128.0f) + EPS);
        const float r0 = bf2f(ra0[q]), r1 = bf2f(ra1[q]);
        MIX[(size_t)tok * 1024 + h * 128 + lane] = f2bf(v0 * rstd * g0 * silu_f(r0));
        MIX[(size_t)tok * 1024 + h * 128 + 64 + lane] = f2bf(v1 * rstd * g1 * silu_f(r1)); }
    __syncthreads();
}

__device__ __forceinline__ void gqa_prep(PRef p, int j, int rb, unsigned char* shm) {
    const int t = tidx(), lane = t & 63, wv = t >> 6;
    const int r0 = rb * 64;
    const bf16_t* PROJ = (const bf16_t*)(p.ws + WS_PROJ);
    bf16_t* QNG = (bf16_t*)(p.ws + WS_QNG); bf16_t* KNG = (bf16_t*)(p.ws + WS_KNG); bf16_t* VTG = (bf16_t*)(p.ws + WS_VTG);
    bf16_t* VL = (bf16_t*)shm;
    const bool ctx = r0 >= T;
    if (!ctx) {
        const float gq0 = p.in[18][j * 128 + lane], gq1 = p.in[18][j * 128 + 64 + lane], gk0 = p.in[19][j * 128 + lane], gk1 = p.in[19][j * 128 + 64 + lane];
        const float inv = exp2f(-(float)(lane & 31) * (13.287712379549449f / 32.0f));
        for (int hb = 0; hb < 6; ++hb) {
            bf16_t r1[8], r2[8];
#pragma unroll
            for (int u = 0; u < 8; ++u) { const int hv = wv * 48 + hb * 8 + u; const int row = r0 + hv / 6, which = hv % 6; const int col = which < 4 ? 1536 + which * 128 : 2048 + (which - 4) * 128;
                r1[u] = PROJ[(size_t)row * 2560 + col + lane]; r2[u] = PROJ[(size_t)row * 2560 + col + 64 + lane]; }
#pragma unroll
            for (int u = 0; u < 8; ++u) { const int hv = wv * 48 + hb * 8 + u; const int row = r0 + hv / 6, which = hv % 6;
                float x1 = bf2f(r1[u]), x2 = bf2f(r2[u]);
                const float ss = wave_sum(x1 * x1 + x2 * x2); const float rstd = rsqrtf(ss * (1.0f / 128.0f) + EPS);
                x1 = x1 * rstd * (which < 4 ? gq0 : gk0); x2 = x2 * rstd * (which < 4 ? gq1 : gk1);
                if (row < 4096) {
                    if (which >= 4) { const int b = row >> 8, tt = row & 255; float* o = p.out + O_CK + ((size_t)(b * 2 + j) * 256 + tt) * 256 + (which - 4) * 128; o[lane] = x1; o[64 + lane] = x2; }
                } else { const int tt = (row - 4096) & 1023; const float pos = lane < 32 ? (float)(tt >> 6) : (float)(tt & 63); const float ang = pos * inv;
                    const float cs = __cosf(ang), sn = __sinf(ang); const float y1 = x1 * cs - x2 * sn, y2 = x1 * sn + x2 * cs; x1 = y1; x2 = y2; }
                if (which < 4) { QNG[(size_t)row * 512 + which * 128 + lane] = f2bf(x1); QNG[(size_t)row * 512 + which * 128 + 64 + lane] = f2bf(x2); }
                else { KNG[(size_t)row * 256 + (which - 4) * 128 + lane] = f2bf(x1); KNG[(size_t)row * 256 + (which - 4) * 128 + 64 + lane] = f2bf(x2); } } }
        { u32x4 vv[4];
#pragma unroll
          for (int i = 0; i < 4; ++i) { const int c = t + 512 * i, rr = c >> 5, piece = c & 31; vv[i] = *(const u32x4*)(PROJ + (size_t)(r0 + rr) * 2560 + 2304 + piece * 8); }
#pragma unroll
          for (int i = 0; i < 4; ++i) { const int c = t + 512 * i, rr = c >> 5, piece = c & 31; const int row = r0 + rr;
              *(u32x4*)(VL + rr * 264 + piece * 8) = vv[i];
              if (row < 4096) { const int b = row >> 8, tt = row & 255; float* o = p.out + O_CV + ((size_t)(b * 2 + j) * 256 + tt) * 256 + piece * 8;
                  f32x4 o0, o1; o0[0] = __uint_as_float(vv[i][0] << 16); o0[1] = __uint_as_float(vv[i][0] & 0xFFFF0000u); o0[2] = __uint_as_float(vv[i][1] << 16); o0[3] = __uint_as_float(vv[i][1] & 0xFFFF0000u);
                  o1[0] = __uint_as_float(vv[i][2] << 16); o1[1] = __uint_as_float(vv[i][2] & 0xFFFF0000u); o1[2] = __uint_as_float(vv[i][3] << 16); o1[3] = __uint_as_float(vv[i][3] & 0xFFFF0000u);
                  *(f32x4*)o = o0; *(f32x4*)(o + 4) = o1; } } }
    } else {
        f32x4 kk[4][2], vv[4][2];
#pragma unroll
        for (int i = 0; i < 4; ++i) { const int c = t + 512 * i, rr = c >> 5, piece = c & 31; const int row = r0 + rr; const int b = (row - T) >> 9, pp = (row - T) & 511;
            const size_t ci = ((size_t)(b * 2 + j) * 512 + pp) * 256 + piece * 8;
            kk[i][0] = *(const f32x4*)(p.in[4] + ci); kk[i][1] = *(const f32x4*)(p.in[4] + ci + 4); vv[i][0] = *(const f32x4*)(p.in[5] + ci); vv[i][1] = *(const f32x4*)(p.in[5] + ci + 4); }
#pragma unroll
        for (int i = 0; i < 4; ++i) { const int c = t + 512 * i, rr = c >> 5, piece = c & 31; const int row = r0 + rr;
            u32x4 ko, vo; ko[0] = pk2(kk[i][0][0], kk[i][0][1]); ko[1] = pk2(kk[i][0][2], kk[i][0][3]); ko[2] = pk2(kk[i][1][0], kk[i][1][1]); ko[3] = pk2(kk[i][1][2], kk[i][1][3]);
            vo[0] = pk2(vv[i][0][0], vv[i][0][1]); vo[1] = pk2(vv[i][0][2], vv[i][0][3]); vo[2] = pk2(vv[i][1][0], vv[i][1][1]); vo[3] = pk2(vv[i][1][2], vv[i][1][3]);
            *(u32x4*)(KNG + (size_t)row * 256 + piece * 8) = ko; *(u32x4*)(VL + rr * 264 + piece * 8) = vo; }
    }
    __syncthreads();
    { const int gd = t & 255, half = t >> 8; unsigned pk[16];
#pragma unroll
      for (int q = 0; q < 16; ++q) { const unsigned lo = VL[(half * 32 + 2 * q) * 264 + gd], hi = VL[(half * 32 + 2 * q + 1) * 264 + gd]; pk[q] = lo | (hi << 16); }
      bf16_t* dst = VTG + (size_t)gd * TK + r0 + half * 32;
#pragma unroll
      for (int q = 0; q < 4; ++q) { u32x4 o; o[0] = pk[4 * q]; o[1] = pk[4 * q + 1]; o[2] = pk[4 * q + 2]; o[3] = pk[4 * q + 3]; *(u32x4*)(dst + 8 * q) = o; } }
    __syncthreads();
}

template <int KS1, int KS2>
__device__ __forceinline__ void attn_wg(const bf16_t* K1, int ld1, const bf16_t* K2, int ld2, const bf16x8 (&bq)[KS1 + KS2], const bf16_t* VT, int ldvt,
                                        int seg0_base, int seg0_tiles, int seg1_base, int tpq, float sc2, bf16_t* out, int ldo, unsigned char* shm) {
    constexpr int KLD = (KS1 + KS2) * 16 + 8, VLD = 36, KTILE = 32 * KLD, VTILE = 128 * VLD;
    bf16_t* Kl = (bf16_t*)shm; bf16_t* Vl = Kl + 4 * KTILE;
    const int t = tidx(), wv = t >> 6, lane = t & 63, r = lane & 31, h = lane >> 5, qblk = wv & 1, kq = wv >> 1;
    f32x16 oacc[4];
#pragma unroll
    for (int i = 0; i < 4; ++i) oacc[i] = zero16();
    float m = -1e30f, l = 0.f;
    u32x4 rk1[4], rk2[2], rv[4];
#define ATT_KB(q_, st_) ({ const int Tt_ = (q_) * tpq + (st_); Tt_ < seg0_tiles ? seg0_base + 32 * Tt_ : seg1_base + 32 * (Tt_ - seg0_tiles); })
#define ATT_LOAD(st_) do { \
        _Pragma("unroll") for (int i_ = 0; i_ < 4; ++i_) { const int kb_ = ATT_KB(i_, st_); \
            rk1[i_] = *(const u32x4*)(K1 + (size_t)(kb_ + (t >> 4)) * ld1 + (t & 15) * 8); \
            rv[i_] = *(const u32x4*)(VT + (size_t)(t >> 2) * ldvt + kb_ + (t & 3) * 8); } \
        if (KS2 > 0) { _Pragma("unroll") for (int i_ = 0; i_ < 2; ++i_) { const int kb_ = ATT_KB((t >> 8) + 2 * i_, st_); \
            rk2[i_] = *(const u32x4*)(K2 + (size_t)(kb_ + ((t & 255) >> 3)) * ld2 + (t & 7) * 8); } } } while (0)
    ATT_LOAD(0);
    for (int st = 0; st < tpq; ++st) {
#pragma unroll
        for (int i = 0; i < 4; ++i) { *(u32x4*)(Kl + i * KTILE + (t >> 4) * KLD + (t & 15) * 8) = rk1[i];
            bf16_t* vd = Vl + i * VTILE + (t >> 2) * VLD + (t & 3) * 8; u32x2 a, b; a[0] = rv[i][0]; a[1] = rv[i][1]; b[0] = rv[i][2]; b[1] = rv[i][3]; *(u32x2*)vd = a; *(u32x2*)(vd + 4) = b; }
        if (KS2 > 0) {
#pragma unroll
            for (int i = 0; i < 2; ++i) *(u32x4*)(Kl + ((t >> 8) + 2 * i) * KTILE + ((t & 255) >> 3) * KLD + KS1 * 16 + (t & 7) * 8) = rk2[i]; }
        __syncthreads();
        if (st + 1 < tpq) ATT_LOAD(st + 1);
        f32x16 s = zero16();
        { const bf16_t* kp = Kl + kq * KTILE + r * KLD + 8 * h;
#pragma unroll
          for (int ks = 0; ks < KS1 + KS2; ++ks) s = mfma32(*(const bf16x8*)(kp + ks * 16), bq[ks], s); }
        float tmax = s[0];
#pragma unroll
        for (int q = 1; q < 16; ++q) tmax = fmaxf(tmax, s[q]);
        tmax = fmaxf(tmax, __shfl_xor(tmax, 32, 64));
        const float mnew = fmaxf(m, tmax); const float alpha = __builtin_amdgcn_exp2f((m - mnew) * sc2); const float mb = mnew * sc2;
        float pr[16]; float rs = 0.f;
#pragma unroll
        for (int q = 0; q < 16; ++q) { pr[q] = __builtin_amdgcn_exp2f(s[q] * sc2 - mb); rs += pr[q]; }
        l = l * alpha + rs; m = mnew;
#pragma unroll
        for (int i = 0; i < 4; ++i) oacc[i] *= alpha;
        bf16x8 pb[2];
#pragma unroll
        for (int si = 0; si < 2; ++si) { u32x4 w; w[0] = pk2(pr[8 * si], pr[8 * si + 1]); w[1] = pk2(pr[8 * si + 2], pr[8 * si + 3]); w[2] = pk2(pr[8 * si + 4], pr[8 * si + 5]); w[3] = pk2(pr[8 * si + 6], pr[8 * si + 7]);
            pb[si] = __builtin_bit_cast(bf16x8, w); }
#pragma unroll
        for (int dt = 0; dt < 4; ++dt) { const bf16_t* vp = Vl + kq * VTILE + (dt * 32 + r) * VLD + 4 * h;
#pragma unroll
            for (int si = 0; si < 2; ++si) { const u32x2 lo = *(const u32x2*)(vp + 16 * si), hi = *(const u32x2*)(vp + 16 * si + 8);
                u32x4 w; w[0] = lo[0]; w[1] = lo[1]; w[2] = hi[0]; w[3] = hi[1];
                oacc[dt] = mfma32(__builtin_bit_cast(bf16x8, w), pb[si], oacc[dt]); } }
        __syncthreads();
    }
#undef ATT_LOAD
#undef ATT_KB
    float* OC = (float*)shm;
    float* ML = OC + 8 * 64 * 64;
    const float ltot = l + __shfl_xor(l, 32, 64);
    ML[(wv * 2 + 0) * 64 + lane] = m; ML[(wv * 2 + 1) * 64 + lane] = ltot;
    { float* oc = OC + (size_t)wv * 4096 + lane;
#pragma unroll
      for (int dt = 0; dt < 4; ++dt)
#pragma unroll
          for (int q = 0; q < 16; ++q) oc[(dt * 16 + q) * 64] = oacc[dt][q]; }
    __syncthreads();
    { float mk[4], lk[4]; float M = -1e30f;
#pragma unroll
      for (int k = 0; k < 4; ++k) { mk[k] = ML[((k * 2 + qblk) * 2 + 0) * 64 + lane]; lk[k] = ML[((k * 2 + qblk) * 2 + 1) * 64 + lane]; M = fmaxf(M, mk[k]); }
      float sk[4]; float L = 0.f;
#pragma unroll
      for (int k = 0; k < 4; ++k) { sk[k] = __builtin_amdgcn_exp2f((mk[k] - M) * sc2); L += sk[k] * lk[k]; }
      const float inv = 1.0f / L; const int dt = kq;
      float o[16];
#pragma unroll
      for (int q = 0; q < 16; ++q) { float v = 0.f;
#pragma unroll
          for (int k = 0; k < 4; ++k) v += sk[k] * OC[(size_t)(k * 2 + qblk) * 4096 + (dt * 16 + q) * 64 + lane];
          o[q] = v * inv; }
#pragma unroll
      for (int rg = 0; rg < 4; ++rg) { u32x2 w; w[0] = pk2(o[4 * rg], o[4 * rg + 1]); w[1] = pk2(o[4 * rg + 2], o[4 * rg + 3]);
          *(u32x2*)(out + (size_t)(qblk * 32 + r) * ldo + dt * 32 + 8 * rg + 4 * h) = w; } }
    __syncthreads();
}

__device__ __forceinline__ void gqa_attn_item(PRef p, int a, unsigned char* shm) {
    const int wv = tidx() >> 6, lane = tidx() & 63, r = lane & 31, h = lane >> 5;
    int hq, q0, s0b, s0t, s1b, tpq;
    if (a < 128) { const int b = a >> 6; hq = (a >> 4) & 3; const int qb = a & 15; q0 = 4096 + b * 1024 + qb * 64; s0b = T + b * 512; s0t = 16; s1b = 4096 + b * 1024; tpq = 12; }
    else { const int aa = a - 128; const int b = aa >> 4; hq = (aa >> 2) & 3; const int qb = aa & 3; q0 = b * 256 + qb * 64; s0b = b * 256; s0t = 8; s1b = 0; tpq = 2; }
    const int g = hq >> 1;
    const bf16_t* QNG = (const bf16_t*)(p.ws + WS_QNG); const bf16_t* KNG = (const bf16_t*)(p.ws + WS_KNG); const bf16_t* VTG = (const bf16_t*)(p.ws + WS_VTG);
    bf16_t* MIX = (bf16_t*)(p.ws + WS_MIX);
    bf16x8 bq[8];
    const bf16_t* qp = QNG + (size_t)(q0 + (wv & 1) * 32 + r) * 512 + hq * 128 + 8 * h;
#pragma unroll
    for (int ks = 0; ks < 8; ++ks) bq[ks] = *(const bf16x8*)(qp + ks * 16);
    attn_wg<8, 0>(KNG + g * 128, 256, nullptr, 0, bq, VTG + (size_t)g * 128 * TK, TK, s0b, s0t, s1b, tpq, 0.08838834764831845f * 1.4426950408889634f,
                  MIX + (size_t)q0 * 1024 + 512 + hq * 128, 1024, shm);
}
__device__ __forceinline__ void mla_attn_item(PRef p, int j, int a, unsigned char* shm) {
    const int wv = tidx() >> 6, lane = tidx() & 63, r = lane & 31, h = lane >> 5;
    int hd, q0, s0b, s0t, s1b, tpq; bool samp;
    if (a < 128) { const int b = a >> 6; hd = (a >> 4) & 3; const int qb = a & 15; q0 = 4096 + b * 1024 + qb * 64; s0b = T + b * 512; s0t = 16; s1b = 4096 + b * 1024; tpq = 12; samp = true; }
    else { const int aa = a - 128; const int b = aa >> 4; hd = (aa >> 2) & 3; const int qb = aa & 3; q0 = b * 256 + qb * 64; s0b = b * 256; s0t = 8; s1b = 0; tpq = 2; samp = false; }
    const bf16_t* QM = (const bf16_t*)(p.ws + WS_QMLA); const bf16_t* KN = (const bf16_t*)(p.ws + WS_KNOPE); const bf16_t* KPE = (const bf16_t*)(p.ws + WS_KPE) + (size_t)j * TK * 64;
    const bf16_t* VTM = (const bf16_t*)(p.ws + WS_VTM); bf16_t* MIX = (bf16_t*)(p.ws + WS_MIX);
    bf16x8 bq[12];
    const int qrow = q0 + (wv & 1) * 32 + r;
    const bf16_t* qp = QM + (size_t)qrow * 768 + hd * 192 + 8 * h;
#pragma unroll
    for (int ks = 0; ks < 12; ++ks) bq[ks] = *(const bf16x8*)(qp + ks * 16);
    if (samp) { const int tt = (qrow - 4096) & 1023; const float prow = (float)(tt >> 6), pcol = (float)(tt & 63);
#pragma unroll
        for (int ksp = 0; ksp < 2; ++ksp) { bf16x8 x1 = bq[8 + ksp], x2 = bq[10 + ksp];
#pragma unroll
            for (int jj = 0; jj < 8; ++jj) { const int i = 16 * ksp + 8 * h + jj; const float inv = exp2f(-(float)(i & 15) * (13.287712379549449f / 16.0f)); const float ang = (i < 16 ? prow : pcol) * inv;
                const float cs = __cosf(ang), sn = __sinf(ang); const float a1 = bf2f((bf16_t)x1[jj]), a2 = bf2f((bf16_t)x2[jj]);
                x1[jj] = (short)f2bf(a1 * cs - a2 * sn); x2[jj] = (short)f2bf(a1 * sn + a2 * cs); }
            bq[8 + ksp] = x1; bq[10 + ksp] = x2; } }
    attn_wg<8, 4>(KN + hd * 128, 512, KPE, 64, bq, VTM + (size_t)hd * 128 * TK, TK, s0b, s0t, s1b, tpq, 0.07216878364870322f * 1.4426950408889634f,
                  MIX + (size_t)q0 * 1024 + 512 + hd * 128, 1024, shm);
}

__device__ __forceinline__ void odd_prep(PRef p, int j, int rb, unsigned char* shm) {
    const int t = tidx(), lane = t & 63, wv = t >> 6; const int r0 = rb * 16;
    const bf16_t* PROJ = (const bf16_t*)(p.ws + WS_PROJ);
    bf16_t* X0 = (bf16_t*)(p.ws + WS_X0); bf16_t* GV = (bf16_t*)(p.ws + WS_GV); bf16_t* GVT = (bf16_t*)(p.ws + WS_GVT);
    bf16_t* GL = (bf16_t*)shm;
    { const int ch = t; float w[3][3], bb[3];
      const int L = r0 < 4096 ? 256 : 1024; const int tt0 = r0 < 4096 ? (r0 & 255) : ((r0 - 4096) & 1023);
      bf16_t u[3][18];
#pragma unroll
      for (int part = 0; part < 3; ++part) { bb[part] = p.in[23][j * 1536 + part * 512 + ch];
#pragma unroll
          for (int tap = 0; tap < 3; ++tap) w[part][tap] = p.in[22][((size_t)j * 3 + tap) * 1536 + part * 512 + ch];
#pragma unroll
          for (int q = 0; q < 18; ++q) { const bool ok = (q == 0) ? (tt0 > 0) : ((q == 17) ? (tt0 + 16 < L) : true);
              u[part][q] = ok ? PROJ[(size_t)(r0 - 1 + q) * 2048 + part * 512 + ch] : (bf16_t)0; } }
#pragma unroll
      for (int rr = 0; rr < 16; ++rr) { const int row = r0 + rr;
          float o[3];
#pragma unroll
          for (int part = 0; part < 3; ++part) o[part] = bf2f(u[part][rr]) * w[part][0] + bf2f(u[part][rr + 1]) * w[part][1] + bf2f(u[part][rr + 2]) * w[part][2] + bb[part];
          const bf16_t gvb = f2bf(o[1] * o[2]);
          X0[(size_t)row * 512 + ch] = f2bf(o[0]); GV[(size_t)row * 512 + ch] = gvb; GL[rr * 520 + ch] = gvb; } }
    __syncthreads();
    { const int ch = t; bf16_t* dst = GVT + (size_t)ch * T + r0;
#pragma unroll
      for (int q = 0; q < 2; ++q) { u32x4 o;
#pragma unroll
          for (int z = 0; z < 4; ++z) { const unsigned lo = GL[(8 * q + 2 * z) * 520 + ch], hi = GL[(8 * q + 2 * z + 1) * 520 + ch]; o[z] = lo | (hi << 16); }
          *(u32x4*)(dst + 8 * q) = o; } }
    bf16_t* CQN = (bf16_t*)(p.ws + WS_CQN); bf16_t* CKV = (bf16_t*)(p.ws + WS_CKV) + (size_t)j * TK * 256; bf16_t* KPE = (bf16_t*)(p.ws + WS_KPE) + (size_t)j * TK * 64;
    for (int rr = wv; rr < 16; rr += 8) { const int row = r0 + rr; const bf16_t* pr = PROJ + (size_t)row * 2048;
        { float v[4]; float ss = 0.f;
#pragma unroll
          for (int q = 0; q < 4; ++q) { v[q] = bf2f(pr[1536 + lane * 4 + q]); ss += v[q] * v[q]; }
          ss = wave_sum(ss); const float rstd = rsqrtf(ss * (1.0f / 256.0f) + EPS); const f32x4 g = *(const f32x4*)(p.in[31] + j * 256 + lane * 4);
          u32x2 o; o[0] = pk2(v[0] * rstd * g[0], v[1] * rstd * g[1]); o[1] = pk2(v[2] * rstd * g[2], v[3] * rstd * g[3]);
          *(u32x2*)(CQN + (size_t)row * 256 + lane * 4) = o; }
        { float v0 = bf2f(pr[1792 + lane * 2]), v1 = bf2f(pr[1792 + lane * 2 + 1]); const float ss = wave_sum(v0 * v0 + v1 * v1); const float rstd = rsqrtf(ss * (1.0f / 128.0f) + EPS);
          v0 = v0 * rstd * p.in[33][j * 128 + lane * 2]; v1 = v1 * rstd * p.in[33][j * 128 + lane * 2 + 1];
          *(unsigned*)(CKV + (size_t)row * 256 + lane * 2) = pk2(v0, v1);
          if (row < 4096) { const int b = row >> 8, tt = row & 255; float* o = p.out + O_CKV + ((size_t)(b * 2 + j) * 256 + tt) * 128 + lane * 2; o[0] = v0; o[1] = v1; } }
        { float v = bf2f(pr[1920 + lane]);
          if (row < 4096) { const int b = row >> 8, tt = row & 255; p.out[O_KPE + ((size_t)(b * 2 + j) * 256 + tt) * 64 + lane] = v; }
          else { const int tt = (row - 4096) & 1023; const float other = __shfl_xor(v, 32, 64); const int i = lane & 31;
              const float inv = exp2f(-(float)(i & 15) * (13.287712379549449f / 16.0f)); const float ang = (i < 16 ? (float)(tt >> 6) : (float)(tt & 63)) * inv; const float cs = __cosf(ang), sn = __sinf(ang);
              v = lane < 32 ? v * cs - other * sn : other * sn + v * cs; }
          KPE[(size_t)row * 64 + lane] = f2bf(v); } }
    __syncthreads();
}

__device__ __forceinline__ void hyena_conv(PRef p, int j, int type, int half, int cg8, unsigned char* shm) {
    const int t = tidx(), lane = t & 63, wv = t >> 6, r = lane & 31, h = lane >> 5;
    const int L = type ? 1024 : 256, nb = L >> 5, tbase = type ? 4096 : half * 2048;
    bf16_t* OUT = (bf16_t*)shm;
    bf16_t* GRL = (bf16_t*)(shm + 32768) + wv * 2048;
    bf16_t* GVL = (bf16_t*)(shm + 65536) + wv * 2048;
    bf16_t* ZR = (bf16_t*)(shm + 98304);
    const int ch = cg8 * 8 + wv;
    const bf16_t* gr = (const bf16_t*)(p.ws + WS_GR) + (size_t)j * 512 * 2560 + (type ? (size_t)512 * 512 : 0) + (size_t)ch * (2 * L);
    for (int i = lane; i < (2 * L) / 8; i += 64) *(u32x4*)(GRL + i * 8) = *(const u32x4*)(gr + i * 8);
    const bf16_t* gvt = (const bf16_t*)(p.ws + WS_GVT) + (size_t)ch * T + tbase;
    for (int i = lane; i < 256; i += 64) *(u32x4*)(GVL + i * 8) = *(const u32x4*)(gvt + i * 8);
    if (t < 8) ((unsigned*)ZR)[t] = 0u;
    __syncthreads();
    f32x16 acc[2];
    acc[0] = zero16(); acc[1] = zero16();
    int cola[2], colb[2];
#pragma unroll
    for (int nt = 0; nt < 2; ++nt) { const int n = 32 * nt + r; const int batch = n / nb, a = n % nb; cola[nt] = a; colb[nt] = batch * L + 8 * h; }
    for (int dl = -(nb - 1); dl <= nb - 1; ++dl) {
#pragma unroll
        for (int kk = 0; kk < 2; ++kk) {
            const int m0 = (L - 1) - (32 * dl + r - 16 * kk - 8 * h);
            bf16x8 af;
#pragma unroll
            for (int jj = 0; jj < 8; ++jj) af[jj] = (short)((const volatile LAS bf16_t*)(LAS bf16_t*)GRL)[m0 + jj];
#pragma unroll
            for (int nt = 0; nt < 2; ++nt) { const int ab = cola[nt] - dl;
                const bf16_t* bp = (ab >= 0 && ab < nb) ? GVL + colb[nt] + 32 * ab + 16 * kk : ZR;
                acc[nt] = mfma32(af, *(const bf16x8*)bp, acc[nt]); }
        }
    }
#pragma unroll
    for (int nt = 0; nt < 2; ++nt) { const int n = 32 * nt + r; const int batch = n / nb, a = n % nb;
#pragma unroll
        for (int q = 0; q < 16; ++q) { const int i = (q & 3) + 8 * (q >> 2) + 4 * h; OUT[(batch * L + 32 * a + i) * 8 + wv] = f2bf(acc[nt][q]); } }
    __syncthreads();
    const bf16_t* X0 = (const bf16_t*)(p.ws + WS_X0); const bf16_t* GV = (const bf16_t*)(p.ws + WS_GV); bf16_t* MIX = (bf16_t*)(p.ws + WS_MIX);
    float sk[8];
#pragma unroll
    for (int q = 0; q < 8; ++q) sk[q] = p.in[24][j * 512 + cg8 * 8 + q];
    for (int tl = t; tl < 2048; tl += 512) { const int row = tbase + tl;
        const bf16x8 y = *(const bf16x8*)(OUT + tl * 8), x0 = *(const bf16x8*)(X0 + (size_t)row * 512 + cg8 * 8), gv = *(const bf16x8*)(GV + (size_t)row * 512 + cg8 * 8);
        float o[8];
#pragma unroll
        for (int q = 0; q < 8; ++q) o[q] = bf2f((bf16_t)x0[q]) * (bf2f((bf16_t)y[q]) + bf2f((bf16_t)gv[q]) * sk[q]);
        u32x4 w; w[0] = pk2(o[0], o[1]); w[1] = pk2(o[2], o[3]); w[2] = pk2(o[4], o[5]); w[3] = pk2(o[6], o[7]);
        *(u32x4*)(MIX + (size_t)row * 1024 + cg8 * 8) = w; }
    __syncthreads();
}

#define XB_TMO      128
#define XB_XCNT(j)  (256  + 64 * (j))
#define XB_XSUB(j)  (1280 + 64 * (j))
#define XB_XGEN(j)  (2304 + 64 * (j))
#define XB_TOP      3328
#define XB_TOPGEN   3392
#define XCD_BAR_WORDS 3456
#define XB_SPIN_CAP (1u << 22)
__device__ __forceinline__ unsigned xb_ld(unsigned* p)              { return __hip_atomic_load(p, __ATOMIC_RELAXED, __HIP_MEMORY_SCOPE_AGENT); }
__device__ __forceinline__ unsigned xb_add(unsigned* p, unsigned v) { return __hip_atomic_fetch_add(p, v, __ATOMIC_RELAXED, __HIP_MEMORY_SCOPE_AGENT); }
__device__ __forceinline__ unsigned xb_xcc_id() { return (unsigned)__builtin_amdgcn_s_getreg((3 << 11) | 20) & 0xFu; }
#define XB_SPIN(cond, bar) do { unsigned _sp = 0; while (cond) { __builtin_amdgcn_s_sleep(1); \
    if ((++_sp & 255u) == 0u) { if (xb_ld(&(bar)[XB_TMO])) break; if (_sp > XB_SPIN_CAP) { atomicAdd(&(bar)[XB_TMO], 1u); break; } } } } while (0)
struct XcdBarrier { unsigned* bar; unsigned x; volatile LAS unsigned* st; };
__device__ __forceinline__ XcdBarrier xcd_barrier_post(unsigned* bar, volatile LAS unsigned* st) {
    XcdBarrier b; b.bar = bar; b.x = xb_xcc_id(); b.st = st;
    if (threadIdx.x == 0) (void)xb_add(&bar[XB_XCNT(b.x)], 1u);
    return b;
}
__device__ __forceinline__ void xcd_barrier_complete(unsigned* bar, unsigned x, unsigned& nloc, unsigned& nx) {
    const unsigned G = gridDim.x * gridDim.y * gridDim.z;
    unsigned sum, cnt, mine, sp = 0u;
    for (;;) {
        sum = 0u; cnt = 0u; mine = 0u;
#pragma unroll
        for (unsigned j = 0; j < 16; ++j) { const unsigned c = xb_ld(&bar[XB_XCNT(j)]); sum += c; cnt += (c > 0u) ? 1u : 0u; mine = (j == x) ? c : mine; }
        if (sum == G) break;
        __builtin_amdgcn_s_sleep(1);
        if ((++sp & 255u) == 0u) { if (xb_ld(&bar[XB_TMO])) break; if (sp > XB_SPIN_CAP) { atomicAdd(&bar[XB_TMO], 1u); break; } }
    }
    nloc = mine > 0u ? mine : 1u; nx = cnt > 0u ? cnt : 1u;
}
__device__ __forceinline__ void xcd_barrier(const XcdBarrier& b) {
    asm volatile("s_waitcnt vmcnt(0)" ::: "memory");
    __syncthreads();
    if (threadIdx.x == 0) {
        unsigned* bar = b.bar;
        __builtin_amdgcn_s_waitcnt(0);
        unsigned nloc = b.st[0], nx = b.st[1];
        if (nloc == 0u) { xcd_barrier_complete(bar, b.x, nloc, nx); b.st[0] = nloc; b.st[1] = nx; }
        const unsigned old = xb_add(&bar[XB_XSUB(b.x)], 1u);
        const unsigned gen = old / nloc;
        if (old + 1u == (gen + 1u) * nloc) {
            __builtin_amdgcn_fence(__ATOMIC_RELEASE, "agent");
            asm volatile("s_waitcnt vmcnt(0)" ::: "memory");
            const unsigned og = xb_add(&bar[XB_TOP], 1u);
            const unsigned tg = og / nx;
            if (og + 1u == (tg + 1u) * nx) xb_add(&bar[XB_TOPGEN], 1u);
            else XB_SPIN(xb_ld(&bar[XB_TOPGEN]) == tg, bar);
            __builtin_amdgcn_fence(__ATOMIC_ACQUIRE, "agent");
            xb_add(&bar[XB_XGEN(b.x)], 1u);
            asm volatile("s_waitcnt vmcnt(0)" ::: "memory");
        } else {
            XB_SPIN(xb_ld(&bar[XB_TOPGEN]) == gen, bar);
            __builtin_amdgcn_fence(__ATOMIC_ACQUIRE, "agent");
            asm volatile("s_waitcnt vmcnt(0)" ::: "memory");
        }
    }
    __syncthreads();
}

__device__ __forceinline__ int next_item(unsigned* q, volatile LAS unsigned* slot) {
    if (threadIdx.x == 0) *slot = __hip_atomic_fetch_add(q, 1u, __ATOMIC_RELAXED, __HIP_MEMORY_SCOPE_AGENT);
    __syncthreads();
    const int it = (int)*slot;
    __syncthreads();
    return it;
}

extern __shared__ __attribute__((aligned(16))) unsigned char g_shm[];

enum { K_PREP = 0, K_NORM, K_GS, K_E2, K_E3, K_O2, K_O4, K_GR_UNUSED, K_F1 };
__device__ __forceinline__ void decode_phase(int ph, int& kind, int& l, int& var) {
    if (ph == 0) { kind = K_PREP; l = 0; var = 0; return; }
    if (ph == N_PHASES - 1) { kind = K_NORM; l = 0; var = 2; return; }
    int q = ph - 1;
    if (q < 8) l = 0; else if (q < 17) { l = 1; q -= 8; } else if (q < 25) { l = 2; q -= 17; } else { l = 3; q -= 25; }
    if ((l & 1) == 0) {
        switch (q) { case 0: kind = K_NORM; var = 0; break; case 1: kind = K_GS; var = 0; break; case 2: kind = K_E2; var = 0; break; case 3: kind = K_E3; var = 0; break;
                     case 4: kind = K_GS; var = 3; break; case 5: kind = K_NORM; var = 1; break; case 6: kind = K_F1; var = 0; break; default: kind = K_GS; var = 4; break; }
    } else {
        switch (q) { case 0: kind = K_NORM; var = 0; break; case 1: kind = K_GS; var = 1; break; case 2: kind = K_O2; var = 0; break; case 3: kind = K_GS; var = 2; break; case 4: kind = K_O4; var = 0; break;
                     case 5: kind = K_GS; var = 3; break; case 6: kind = K_NORM; var = 1; break; case 7: kind = K_F1; var = 0; break; default: kind = K_GS; var = 4; break; }
    }
}

__global__ void __launch_bounds__(512, 2) mega(Params p_arg) {
    cg::grid_group grid = cg::this_grid();
    const int ph_lo = get_params()->ph_lo, ph_hi = get_params()->ph_hi;
    volatile LAS unsigned* xb_st = (volatile LAS unsigned*)((LAS unsigned char*)g_shm + (LDS_BYTES - 16));
    XcdBarrier xb; xb.bar = (unsigned*)(get_params()->ws + WS_BAR); xb.x = 0; xb.st = xb_st;
    if (ph_hi - ph_lo > 1) { if (threadIdx.x == 0) { xb_st[0] = 0u; xb_st[1] = 0u; } __syncthreads(); xb = xcd_barrier_post(xb.bar, xb_st); }
    for (int ph = ph_lo; ph < ph_hi; ++ph) {
        PRef p = *get_params();
        unsigned char* shm = g_shm;
        LAS unsigned char* lds = (LAS unsigned char*)g_shm;
        const int wg = bidx(), G = gdim();
        unsigned char* ws = p.ws;
        int kind, l, var; decode_phase(ph, kind, l, var);
        const int j = l >> 1;
        const int nrep = (kind == REP_KIND && (REP_VAR < 0 || var == REP_VAR)) ? 1 + REP_N : 1;
        for (int rep = 0; rep < nrep; ++rep)
        switch (kind) {
        case K_PREP: phase_prep(p, shm); break;
        case K_NORM: phase_norm(p, l, var); break;
        case K_GS: {
            const int nsub = var == 2 ? 3 : 1;
            if (var == 0) phase_zgemm(p, j, shm);
            for (int gi = 0; gi < nsub; ++gi) {
                pg8::Gemm g; pg8::EpiStore E; int c = wg, GG = G, ns = 1, ksub = 0;
                if (var == 3) { g = {(const bf16_t*)(ws + WS_MIX), (const bf16_t*)(ws + ((l & 1) ? WS_WOUTO : WS_WOUTE)) + (size_t)j * 1024 * 1024, T, 1024, 512, 1024}; E = {(bf16_t*)(ws + WS_P), 1024, 1024, (size_t)T * 1024}; ns = 2; ksub = 512; }
                else if (var == 4) { g = {(const bf16_t*)(ws + WS_ACT), (const bf16_t*)(ws + WS_WFO) + (size_t)l * 1024 * 2816, T, 1024, 1408, 2816}; E = {(bf16_t*)(ws + WS_P), 1024, 1024, (size_t)T * 1024}; ns = 2; ksub = 1408; }
                else if (var == 0) { g = {(const bf16_t*)(ws + WS_H), (const bf16_t*)(ws + WS_WINE) + (size_t)j * 2560 * 1024, T, 2560, 1024, 1024}; E = {(bf16_t*)(ws + WS_PROJ), 2560, 2560, 0}; }
                else if (var == 1) { g = {(const bf16_t*)(ws + WS_H), (const bf16_t*)(ws + WS_WINO) + (size_t)j * 2048 * 1024, T, 2048, 1024, 1024}; E = {(bf16_t*)(ws + WS_PROJ), 2048, 1984, 0}; }
                else {
                    int off;
                    if (gi == 0) { g = {(const bf16_t*)(ws + WS_CQN), (const bf16_t*)(ws + WS_WQB) + (size_t)j * 768 * 256, T, 768, 256, 256}; E = {(bf16_t*)(ws + WS_QMLA), 768, 768, 0}; off = 0; }
                    else if (gi == 1) { g = {(const bf16_t*)(ws + WS_CKV) + (size_t)j * TK * 256, (const bf16_t*)(ws + WS_WKVK) + (size_t)j * 512 * 256, TK, 512, 256, 256}; E = {(bf16_t*)(ws + WS_KNOPE), 512, 512, 0}; off = 72; }
                    else { g = {(const bf16_t*)(ws + WS_WKVV) + (size_t)j * 512 * 256, (const bf16_t*)(ws + WS_CKV) + (size_t)j * TK * 256, 512, TK, 256, 256}; E = {(bf16_t*)(ws + WS_VTM), TK, TK, 0}; off = 128; }
                    if (G >= 184) { c = wg - off; GG = 256; }
                }
                pg8::Order S; S.init(g.M, g.N, GG, c, ns, ksub);
                pg8::gemm_phase(lds, g, S, E);
            }
            if (var == 4 && l < 3 && G == 256) { if (wg >= 192) conv_layer(p, l + 1, wg - 192, 64, (float*)shm, 2); }
        } break;
        case K_E2: {
            unsigned* q = (unsigned*)(ws + WS_BAR) + 16 + l * 4; volatile LAS unsigned* slot = (volatile LAS unsigned*)((LAS unsigned char*)g_shm + (LDS_BYTES - 32));
            for (;;) { const int it = next_item(q, slot); if (it >= 880) break; if (it < 112) gqa_prep(p, j, it, shm); else gla_pass_a(p, j, it - 112, shm); }
        } break;
        case K_E3: {
            unsigned* q = (unsigned*)(ws + WS_BAR) + 17 + l * 4; volatile LAS unsigned* slot = (volatile LAS unsigned*)((LAS unsigned char*)g_shm + (LDS_BYTES - 32));
            for (;;) { const int it = next_item(q, slot); if (it >= 768) break;
                if (it < 128 || (it >= 256 && it < 512)) gla_pass_b(p, j, it < 128 ? 256 + it : it - 256, shm); else gqa_attn_item(p, it < 256 ? it - 128 : it - 384, shm); }
        } break;
        case K_O2:
            for (int it = wg; it < 384; it += G) odd_prep(p, j, it, shm);
            break;
        case K_O4: {
            unsigned* q = (unsigned*)(ws + WS_BAR) + 18 + l * 4; volatile LAS unsigned* slot = (volatile LAS unsigned*)((LAS unsigned char*)g_shm + (LDS_BYTES - 32));
            for (;;) { const int it = next_item(q, slot); if (it >= 576) break;
                if (it < 192) hyena_conv(p, j, it < 64 ? 1 : 0, it < 64 ? 0 : (it - 64) >> 6, it < 64 ? it : (it - 64) & 63, shm);
                else mla_attn_item(p, j, it - 192, shm); }
        } break;
        default: {
            pg8::Gemm g{(const bf16_t*)(ws + WS_H), (const bf16_t*)(ws + WS_WFI) + (size_t)l * 5632 * 1024, T, 5632, 1024, 1024};
            pg8::Order S; S.init(T, 5632, G, wg); pg8::EpiSwiglu E{(bf16_t*)(ws + WS_ACT)};
            pg8::gemm_phase(lds, g, S, E);
            if (l < 3) {
                const int nlast = 528 - 2 * G;
                if (G == 256 && nlast > 0) { if (wg >= nlast) conv_layer(p, l + 1, wg - nlast, G - nlast, (float*)shm, 1); }
                else conv_layer(p, l + 1, wg, G, (float*)shm); }
        } break;
        }
        if (ph + 1 < ph_hi) { if (USE_CG_SYNC || ph_hi > 100000) grid.sync(); else xcd_barrier(xb); }
        for (int es = 0; es < EXTRA_SYNC; ++es) xcd_barrier(xb);
    }
}

extern "C" void kernel_launch(void* const* d_in, const int* in_sizes, int n_in, void* d_out, int out_size, void* d_ws, size_t ws_size, hipStream_t stream) {
    static int grid = 0;
    if (grid == 0) {
        if (n_in != NIN || ws_size < WS_END) { fprintf(stderr, "kernel_launch: unexpected n_in %d / ws_size %zu (need %zu)\n", n_in, ws_size, (size_t)WS_END); grid = -1; return; }
        int dev = 0, cus = 0, per_cu = 0;
        hipGetDevice(&dev); hipDeviceGetAttribute(&cus, hipDeviceAttributeMultiprocessorCount, dev);
        if (hipFuncSetAttribute((const void*)mega, hipFuncAttributeMaxDynamicSharedMemorySize, LDS_BYTES) != hipSuccess) { fprintf(stderr, "kernel_launch: hipFuncSetAttribute failed\n"); grid = -1; return; }
        if (hipOccupancyMaxActiveBlocksPerMultiprocessor(&per_cu, (const void*)mega, 512, LDS_BYTES) != hipSuccess || per_cu < 1) { fprintf(stderr, "kernel_launch: occupancy query says %d\n", per_cu); per_cu = 1; }
        (void)hipGetLastError();
        grid = cus;
        if (grid > 256) grid = 256;
    }
    if (grid < 0) return;
    Params p{};
    for (int i = 0; i < NIN; ++i) p.in[i] = (const float*)d_in[i];
    p.out = (float*)d_out; p.ws = (unsigned char*)d_ws;
#if MULTI_LAUNCH
    for (int ph = 0; ph < N_PHASES; ++ph) { p.ph_lo = ph; p.ph_hi = ph + 1; hipLaunchKernelGGL(mega, dim3(grid), dim3(512), LDS_BYTES, stream, p); }
#else
    p.ph_lo = 0; p.ph_hi = N_PHASES;
    if (hipMemsetAsync((unsigned char*)d_ws + WS_BAR, 0, 16384, stream) != hipSuccess) { fprintf(stderr, "kernel_launch: memset of barrier words failed\n"); return; }
    void* args[] = {&p};
    hipError_t e = hipLaunchCooperativeKernel((const void*)mega, dim3(grid), dim3(512), args, LDS_BYTES, stream);
    if (e != hipSuccess) fprintf(stderr, "cooperative launch failed: %s (grid %d)\n", hipGetErrorString(e), grid);
#endif
}
```

```cpp
#include <hip/hip_runtime.h>
#include <hip/hip_cooperative_groups.h>
#include <cstdio>
namespace cg = cooperative_groups;

#ifndef REP_KIND
#define REP_KIND -1
#endif
#ifndef REP_VAR
#define REP_VAR -1
#endif
#ifndef REP_N
#define REP_N 0
#endif
#ifndef REP_SUB
#define REP_SUB 0
#endif
#ifndef USE_CG_SYNC
#define USE_CG_SYNC 0
#endif
#ifndef EXTRA_SYNC
#define EXTRA_SYNC 0
#endif
#ifndef MULTI_LAUNCH
#define MULTI_LAUNCH 0
#endif

#define LAS __attribute__((address_space(3)))
typedef unsigned short bf16_t;
typedef short bf16x8 __attribute__((ext_vector_type(8)));
typedef float f32x4 __attribute__((ext_vector_type(4)));
typedef float f32x16 __attribute__((ext_vector_type(16)));
typedef unsigned u32x4 __attribute__((ext_vector_type(4)));
typedef unsigned u32x2 __attribute__((ext_vector_type(2)));

constexpr int T = 6144, TK = 7168;
constexpr int NIN = 39;
constexpr float EPS = 1e-6f;
constexpr int N_PHASES = 36;

constexpr size_t O_YP = 0, O_YS = 4194304, O_SF = 6291456, O_SB = 7340032, O_CK = 8388608, O_CV = 10485760, O_CKV = 12582912, O_KPE = 13631488;

constexpr size_t al256(size_t x) { return (x + 255) & ~(size_t)255; }
constexpr size_t WS_X = 0;
constexpr size_t WS_H = WS_X + al256((size_t)T * 1024 * 4);
constexpr size_t WS_MOD = WS_H + al256((size_t)T * 1024 * 2);
constexpr size_t WS_PROJ = WS_MOD + al256((size_t)4 * 3 * 6144 * 4);
constexpr size_t WS_ZG = WS_PROJ + al256((size_t)T * 2560 * 2);
constexpr size_t WS_WZ = WS_ZG + al256((size_t)T * 32 * 4);
constexpr size_t WS_MIX = WS_WZ + al256((size_t)2 * 32 * 1024 * 2);
constexpr size_t WS_ACT = WS_MIX + al256((size_t)T * 1024 * 2);
constexpr size_t WS_WINE = WS_ACT + al256((size_t)T * 2816 * 2);
constexpr size_t WS_WOUTE = WS_WINE + al256((size_t)2 * 2560 * 1024 * 2);
constexpr size_t WS_WINO = WS_WOUTE + al256((size_t)2 * 1024 * 1024 * 2);
constexpr size_t WS_WOUTO = WS_WINO + al256((size_t)2 * 2048 * 1024 * 2);
constexpr size_t WS_WQB = WS_WOUTO + al256((size_t)2 * 1024 * 1024 * 2);
constexpr size_t WS_WKVK = WS_WQB + al256((size_t)2 * 768 * 256 * 2);
constexpr size_t WS_WKVV = WS_WKVK + al256((size_t)2 * 512 * 256 * 2);
constexpr size_t WS_WFI = WS_WKVV + al256((size_t)2 * 512 * 256 * 2);
constexpr size_t WS_WFO = WS_WFI + al256((size_t)4 * 5632 * 1024 * 2);
constexpr size_t WS_DS = WS_WFO + al256((size_t)4 * 1024 * 2816 * 2);
constexpr size_t WS_DEC = WS_DS + al256((size_t)768 * 64 * 128 * 4);
constexpr size_t WS_QNG = WS_DEC + al256((size_t)768 * 64 * 4);
constexpr size_t WS_KNG = WS_QNG + al256((size_t)T * 512 * 2);
constexpr size_t WS_VTG = WS_KNG + al256((size_t)TK * 256 * 2);
constexpr size_t WS_GR = WS_VTG + al256((size_t)256 * TK * 2);
constexpr size_t WS_X0 = WS_GR + al256((size_t)2 * 512 * 2560 * 2);
constexpr size_t WS_GV = WS_X0 + al256((size_t)T * 512 * 2);
constexpr size_t WS_GVT = WS_GV + al256((size_t)T * 512 * 2);
constexpr size_t WS_CQN = WS_GVT + al256((size_t)512 * T * 2);
constexpr size_t WS_CKV = WS_CQN + al256((size_t)T * 256 * 2);
constexpr size_t WS_KPE = WS_CKV + al256((size_t)2 * TK * 256 * 2);
constexpr size_t WS_QMLA = WS_KPE + al256((size_t)2 * TK * 64 * 2);
constexpr size_t WS_KNOPE = WS_QMLA + al256((size_t)T * 768 * 2);
constexpr size_t WS_VTM = WS_KNOPE + al256((size_t)TK * 512 * 2);
constexpr size_t WS_BAR = WS_VTM + al256((size_t)512 * TK * 2);
constexpr size_t WS_P = WS_BAR + 16384;
constexpr size_t WS_END = WS_P + al256((size_t)2 * T * 1024 * 2);

constexpr int LDS_BYTES = 139264;

struct Params {
    const float* in[NIN];
    float* out;
    unsigned char* ws;
    int ph_lo, ph_hi;
};

typedef const __attribute__((address_space(4))) Params& PRef;
typedef const __attribute__((address_space(4))) Params* PPtr;
__device__ __forceinline__ PPtr get_params() { PPtr q = (PPtr)__builtin_amdgcn_kernarg_segment_ptr(); asm volatile("" : "+s"(q)); return q; }

__device__ __forceinline__ int tidx() { int t = (int)__builtin_amdgcn_workitem_id_x(); asm volatile("" : "+v"(t)); return t; }
__device__ __forceinline__ int bidx() { int t = (int)__builtin_amdgcn_workgroup_id_x(); asm volatile("" : "+s"(t)); return t; }
__device__ __forceinline__ int gdim() { int t = (int)__ockl_get_num_groups(0); asm volatile("" : "+s"(t)); return t; }
__device__ __forceinline__ bf16_t f2bf(float f) { unsigned u = __float_as_uint(f); u += 0x7FFFu + ((u >> 16) & 1u); return (bf16_t)(u >> 16); }
__device__ __forceinline__ float bf2f(bf16_t b) { return __uint_as_float(((unsigned)b) << 16); }
typedef __bf16 bf16v2_t __attribute__((ext_vector_type(2)));
typedef float f32v2_t __attribute__((ext_vector_type(2)));
__device__ __forceinline__ unsigned pk2(float lo, float hi) { f32v2_t v; v[0] = lo; v[1] = hi; return __builtin_bit_cast(unsigned, __builtin_convertvector(v, bf16v2_t)); }
__device__ __forceinline__ float wave_sum(float v) {
#pragma unroll
    for (int o = 32; o > 0; o >>= 1) v += __shfl_xor(v, o, 64);
    return v;
}
__device__ __forceinline__ float silu_f(float g) { return g * __builtin_amdgcn_rcpf(1.0f + __expf(-g)); }
__device__ __forceinline__ int cvec_of(int r) { return r < 4096 ? 0 : 1 + ((r - 4096) >> 10); }
__device__ __forceinline__ f32x16 zero16() { f32x16 z;
#pragma unroll
    for (int i = 0; i < 16; ++i) z[i] = 0.f; return z; }
__device__ __forceinline__ f32x16 mfma32(bf16x8 a, bf16x8 b, f32x16 c) { return __builtin_amdgcn_mfma_f32_32x32x16_bf16(a, b, c, 0, 0, 0); }
__device__ __forceinline__ f32x16 mma_rows(const bf16_t* A, int lda, const bf16_t* B, int ldb, int K, f32x16 acc) {
    const int lane = tidx() & 63, r = lane & 31, h = lane >> 5;
    for (int k0 = 0; k0 < K; k0 += 16) {
        bf16x8 a = *(const bf16x8*)(A + r * lda + k0 + 8 * h);
        bf16x8 b = *(const bf16x8*)(B + r * ldb + k0 + 8 * h);
        acc = mfma32(a, b, acc);
    }
    return acc;
}

namespace pg8 {
constexpr int BM = 256, BK = 64, HALF = 128, HTB = HALF * BK * 2, STAGE_BYTES = 8 * HTB, NXCD = 8, WGM = 8;
__device__ __forceinline__ int lds_byte(int r, int c) { const int st = (r >> 4) * 2 + (c >> 5), rr = r & 15, cc = c & 31, ob = rr * 64 + cc * 2; return st * 1024 + (ob ^ (((ob >> 9) & 1) << 5)); }
__device__ __forceinline__ void stage_rc(int b, int& R, int& C) { const int st = b / 1024, sb = b % 1024, swz = sb ^ (((sb >> 9) & 1) << 5); R = (st >> 1) * 16 + swz / 64; C = (st & 1) * 32 + (swz % 64) / 2; }
__device__ __forceinline__ int perm32(int rho) { const int n = rho >> 4, i = rho & 15; return 8 * (i >> 2) + 4 * n + (i & 3); }
struct Unit { int pm, pn, sp, ko; };
struct Gemm { const bf16_t* A; const bf16_t* Bt; int M, N, K, ld; };
struct Order {
    int nM, nN, nwg, G, c, ns, ksub;
    __device__ void init(int M, int N, int G_, int c_, int ns_ = 1, int ksub_ = 0) { nM = M / BM; nN = N / BM; nwg = nM * nN; G = G_; c = c_; ns = ns_; ksub = ksub_; }
    __device__ bool next(int i, Unit& u) const {
        if (c < 0) return false;
        const long L = (long)i * G + c; if (L >= (long)nwg * ns) return false;
        const int sp = (int)(L / nwg);
        int wgid = (int)(L % nwg); { const int q = nwg / NXCD, r = nwg % NXCD, xcd = wgid % NXCD, off = wgid / NXCD; wgid = (xcd < r ? xcd * (q + 1) : r * (q + 1) + (xcd - r) * q) + off; }
        const int nig = WGM * nN, gid = wgid / nig, fm = gid * WGM, gsz = (nM - fm) < WGM ? (nM - fm) : WGM;
        u.pm = fm + ((wgid % nig) % gsz); u.pn = (wgid % nig) / gsz; u.sp = sp; u.ko = sp * ksub; return true;
    }
};

template <class Epi>
__device__ __forceinline__ void gemm_phase(LAS unsigned char* lds, const Gemm g, const Order& S, const Epi& E) {
    const int tid = tidx(), wid = __builtin_amdgcn_readfirstlane(tid >> 6), lane = tid & 63, wr = wid >> 2, wc = wid & 3, fr = lane & 15, fq = lane >> 4;
    const int K = g.ld, nt = g.K / BK;
    unsigned voffA[2], voffB[2];
#pragma unroll
    for (int i = 0; i < 2; ++i) { int R, C; stage_rc(tid * 16 + i * 8192, R, C); const int Rb = Epi::PERM ? ((R & ~31) + perm32(R & 31)) : R;
        voffA[i] = (unsigned)(R * K + C) * 2u; voffB[i] = (unsigned)(Rb * K + C) * 2u; }
    const size_t kstep = (size_t)(BK * 2);
    const size_t hstep = (size_t)HALF * K * 2;
    const size_t tstep = 2 * hstep;
    const unsigned ldsw = (unsigned)wid * 1024u;
    const int aoff = lds_byte(wr * 64 + fr, fq * 8), boff = lds_byte(wc * 32 + fr, fq * 8);
#define PG8_SA(b, h) (((b) * 2 + (h)) * HTB)
#define PG8_SB(b, h) ((4 + (b) * 2 + (h)) * HTB)
#define PG8_STAGE(bufoff, gbase, voff) do { _Pragma("unroll") for (int _i = 0; _i < 2; ++_i) \
        __builtin_amdgcn_global_load_lds((const unsigned*)((const char*)(gbase) + (voff)[_i]), (LAS unsigned*)(lds + (bufoff) + ldsw + _i * 8192), 16, 0, 0); } while (0)
#define PG8_LDA(dst, b, h) do { _Pragma("unroll") for (int m = 0; m < 4; ++m) _Pragma("unroll") for (int k = 0; k < 2; ++k) dst[m][k] = *(const LAS bf16x8*)(lds + PG8_SA(b, h) + aoff + m * 2048 + k * 1024); } while (0)
#define PG8_LDB(dst, b, h) do { _Pragma("unroll") for (int n = 0; n < 2; ++n) _Pragma("unroll") for (int k = 0; k < 2; ++k) dst[n][k] = *(const LAS bf16x8*)(lds + PG8_SB(b, h) + boff + n * 2048 + k * 1024); } while (0)
#define PG8_MMA(ai, bj, At, Bt) do { __builtin_amdgcn_s_setprio(1); _Pragma("unroll") for (int m = 0; m < 4; ++m) _Pragma("unroll") for (int n = 0; n < 2; ++n) _Pragma("unroll") for (int k = 0; k < 2; ++k) \
        acc[ai][bj][m][n] = __builtin_amdgcn_mfma_f32_16x16x32_bf16(Bt[n][k], At[m][k], acc[ai][bj][m][n], 0, 0, 0); __builtin_amdgcn_s_setprio(0); } while (0)
#define PG8_WAIT_V(n) asm volatile("s_waitcnt vmcnt(" #n ")" ::: "memory")
#define PG8_WAIT_L(n) asm volatile("s_waitcnt lgkmcnt(" #n ")" ::: "memory")
#define PG8_BAR __builtin_amdgcn_s_barrier()
#define PG8_SCHED __builtin_amdgcn_sched_barrier(0)
    Unit cur, nxt; int ui = 0;
    if (!S.next(0, cur)) return;
    f32x4 acc[2][2][4][2];
#pragma unroll
    for (int a = 0; a < 2; ++a)
#pragma unroll
        for (int b = 0; b < 2; ++b)
#pragma unroll
            for (int m = 0; m < 4; ++m)
#pragma unroll
                for (int n = 0; n < 2; ++n) acc[a][b][m][n] = (f32x4){0.f, 0.f, 0.f, 0.f};
    bf16x8 At[4][2], B0[2][2], B1[2][2];
    const char* cA = (const char*)g.A + (size_t)cur.pm * tstep + (size_t)cur.ko * 2; const char* cB = (const char*)g.Bt + (size_t)cur.pn * tstep + (size_t)cur.ko * 2;
    PG8_STAGE(PG8_SB(0, 0), cB, voffB); PG8_STAGE(PG8_SA(0, 0), cA, voffA); PG8_STAGE(PG8_SB(0, 1), cB + hstep, voffB); PG8_STAGE(PG8_SA(0, 1), cA + hstep, voffA);
    if (wr == 1) PG8_BAR;
    PG8_WAIT_V(4); PG8_BAR;
    PG8_STAGE(PG8_SB(1, 0), cB + kstep, voffB); PG8_STAGE(PG8_SA(1, 0), cA + kstep, voffA); PG8_STAGE(PG8_SB(1, 1), cB + hstep + kstep, voffB);
    PG8_WAIT_V(6); PG8_BAR;
    for (;;) {
        const bool has_next = S.next(ui + 1, nxt);
        const char* nA = has_next ? (const char*)g.A + (size_t)nxt.pm * tstep + (size_t)nxt.ko * 2 : cA; const char* nB = has_next ? (const char*)g.Bt + (size_t)nxt.pn * tstep + (size_t)nxt.ko * 2 : cB;
        for (int t = 0; t < nt; t += 2) {
            const bool last = (t == nt - 2);
            const char* a1 = cA + (size_t)(t + 1) * kstep;
            const char* a2 = last ? nA : cA + (size_t)(t + 2) * kstep; const char* b2 = last ? nB : cB + (size_t)(t + 2) * kstep;
            const char* a3 = a2 + kstep; const char* b3 = b2 + kstep;
            PG8_LDB(B0, 0, 0); PG8_SCHED; PG8_LDA(At, 0, 0); PG8_STAGE(PG8_SA(1, 1), a1 + hstep, voffA);
            PG8_WAIT_L(8); PG8_BAR; PG8_WAIT_L(0); PG8_MMA(0, 0, At, B0); PG8_BAR; PG8_SCHED;
            PG8_LDB(B1, 0, 1); PG8_STAGE(PG8_SB(0, 0), b2, voffB);
            PG8_BAR; PG8_WAIT_L(0); PG8_MMA(0, 1, At, B1); PG8_BAR;
            PG8_LDA(At, 0, 1); PG8_STAGE(PG8_SA(0, 0), a2, voffA);
            PG8_BAR; PG8_WAIT_L(0); PG8_MMA(1, 0, At, B0); PG8_BAR; PG8_SCHED;
            PG8_STAGE(PG8_SB(0, 1), b2 + hstep, voffB);
            PG8_WAIT_V(6); PG8_BAR; PG8_MMA(1, 1, At, B1); PG8_BAR;
            PG8_LDB(B0, 1, 0); PG8_SCHED; PG8_LDA(At, 1, 0); PG8_STAGE(PG8_SA(0, 1), a2 + hstep, voffA);
            PG8_WAIT_L(8); PG8_BAR; PG8_WAIT_L(0); PG8_MMA(0, 0, At, B0); PG8_BAR; PG8_SCHED;
            PG8_LDB(B1, 1, 1); PG8_STAGE(PG8_SB(1, 0), b3, voffB);
            PG8_BAR; PG8_WAIT_L(0); PG8_MMA(0, 1, At, B1); PG8_BAR;
            PG8_LDA(At, 1, 1); PG8_STAGE(PG8_SA(1, 0), a3, voffA);
            PG8_BAR; PG8_WAIT_L(0); PG8_MMA(1, 0, At, B0); PG8_BAR; PG8_SCHED;
            PG8_STAGE(PG8_SB(1, 1), b3 + hstep, voffB);
            PG8_WAIT_V(6); PG8_BAR; PG8_MMA(1, 1, At, B1); PG8_BAR;
        }
        E(acc, cur, wr, wc, fr, fq);
        if (!has_next) break;
#pragma unroll
        for (int a = 0; a < 2; ++a)
#pragma unroll
            for (int b = 0; b < 2; ++b)
#pragma unroll
                for (int m = 0; m < 4; ++m)
#pragma unroll
                    for (int n = 0; n < 2; ++n) acc[a][b][m][n] = (f32x4){0.f, 0.f, 0.f, 0.f};
        cur = nxt; cA = nA; cB = nB; ++ui;
    }
    PG8_WAIT_V(0);
    if (wr == 0) PG8_BAR;
    PG8_BAR;
#undef PG8_SA
#undef PG8_SB
#undef PG8_STAGE
#undef PG8_LDA
#undef PG8_LDB
#undef PG8_MMA
#undef PG8_WAIT_V
#undef PG8_WAIT_L
#undef PG8_BAR
#undef PG8_SCHED
}
struct EpiStore {
    static constexpr bool PERM = true;
    bf16_t* O; int ldc; int ncols; size_t split_stride;
    __device__ __forceinline__ void operator()(const f32x4 (&acc)[2][2][4][2], const Unit& u, int wr, int wc, int fr, int fq) const {
        const int row0 = u.pm * BM + wr * 64 + fr, col0 = u.pn * BM + wc * 32 + 8 * fq;
#pragma unroll
        for (int ai = 0; ai < 2; ++ai)
#pragma unroll
            for (int m = 0; m < 4; ++m) { bf16_t* rowp = O + (size_t)u.sp * split_stride + (size_t)(row0 + ai * HALF + m * 16) * ldc;
#pragma unroll
                for (int bj = 0; bj < 2; ++bj) { const int col = col0 + bj * HALF; if (col < ncols) {
                    const f32x4 v0 = acc[ai][bj][m][0], v1 = acc[ai][bj][m][1];
                    u32x4 o; o[0] = pk2(v0[0], v0[1]); o[1] = pk2(v0[2], v0[3]); o[2] = pk2(v1[0], v1[1]); o[3] = pk2(v1[2], v1[3]);
                    *(u32x4*)(rowp + col) = o; } } }
    }
};
struct EpiSwiglu {
    static constexpr bool PERM = true;
    bf16_t* O;
    __device__ __forceinline__ void operator()(const f32x4 (&acc)[2][2][4][2], const Unit& u, int wr, int wc, int fr, int fq) const {
        const int row0 = u.pm * BM + wr * 64 + fr, col0 = u.pn * 128 + wc * 32 + 8 * fq;
#pragma unroll
        for (int ai = 0; ai < 2; ++ai)
#pragma unroll
            for (int m = 0; m < 4; ++m) { bf16_t* rowp = O + (size_t)(row0 + ai * HALF + m * 16) * 2816 + col0;
                float r[8];
#pragma unroll
                for (int n = 0; n < 2; ++n)
#pragma unroll
                    for (int q = 0; q < 4; ++q) r[n * 4 + q] = silu_f(acc[ai][0][m][n][q]) * acc[ai][1][m][n][q];
                u32x4 o; o[0] = pk2(r[0], r[1]); o[1] = pk2(r[2], r[3]); o[2] = pk2(r[4], r[5]); o[3] = pk2(r[6], r[7]);
                *(u32x4*)rowp = o; }
    }
};
}

struct Job { const float* src; int ld, Ks, mode; bf16_t* dst; int Nd, Kd; };
__device__ __forceinline__ int job_srccol(int mode, int n0) {
    switch (mode) {
        case 0: return n0;
        case 1: return n0 < 1536 ? n0 : n0 + 32;
        case 2: return 1536;
        case 3: return n0 < 1984 ? n0 : -1;
        case 4: return (n0 >> 7) * 256 + (n0 & 127);
        case 5: return (n0 >> 7) * 256 + 128 + (n0 & 127);
        default: { const int pn = n0 >> 8, x0 = n0 & 255; return x0 < 128 ? pn * 128 + x0 : 2816 + pn * 128 + x0 - 128; }
    }
}
__device__ __forceinline__ Job get_job(PRef p, int idx) {
    Job j; unsigned char* ws = p.ws;
    if (idx < 2)       { const int i = idx;      j = {p.in[12] + (size_t)i * 1024 * 2592, 2592, 1024, 1, (bf16_t*)(ws + WS_WINE) + (size_t)i * 2560 * 1024, 2560, 1024}; }
    else if (idx < 4)  { const int i = idx - 2;  j = {p.in[12] + (size_t)i * 1024 * 2592, 2592, 1024, 2, (bf16_t*)(ws + WS_WZ) + (size_t)i * 32 * 1024, 32, 1024}; }
    else if (idx < 6)  { const int i = idx - 4;  j = {p.in[20] + (size_t)i * 1024 * 1024, 1024, 1024, 0, (bf16_t*)(ws + WS_WOUTE) + (size_t)i * 1024 * 1024, 1024, 1024}; }
    else if (idx < 8)  { const int i = idx - 6;  j = {p.in[21] + (size_t)i * 1024 * 1984, 1984, 1024, 3, (bf16_t*)(ws + WS_WINO) + (size_t)i * 2048 * 1024, 2048, 1024}; }
    else if (idx < 10) { const int i = idx - 8;  j = {p.in[35] + (size_t)i * 1024 * 1024, 1024, 1024, 0, (bf16_t*)(ws + WS_WOUTO) + (size_t)i * 1024 * 1024, 1024, 1024}; }
    else if (idx < 12) { const int i = idx - 10; j = {p.in[32] + (size_t)i * 256 * 768, 768, 256, 0, (bf16_t*)(ws + WS_WQB) + (size_t)i * 768 * 256, 768, 256}; }
    else if (idx < 14) { const int i = idx - 12; j = {p.in[34] + (size_t)i * 128 * 1024, 1024, 128, 4, (bf16_t*)(ws + WS_WKVK) + (size_t)i * 512 * 256, 512, 256}; }
    else if (idx < 16) { const int i = idx - 14; j = {p.in[34] + (size_t)i * 128 * 1024, 1024, 128, 5, (bf16_t*)(ws + WS_WKVV) + (size_t)i * 512 * 256, 512, 256}; }
    else if (idx < 20) { const int i = idx - 16; j = {p.in[36] + (size_t)i * 1024 * 5632, 5632, 1024, 6, (bf16_t*)(ws + WS_WFI) + (size_t)i * 5632 * 1024, 5632, 1024}; }
    else               { const int i = idx - 20; j = {p.in[37] + (size_t)i * 2816 * 1024, 1024, 2816, 0, (bf16_t*)(ws + WS_WFO) + (size_t)i * 1024 * 2816, 1024, 2816}; }
    return j;
}
constexpr int N_JOBS = 24;

__device__ __forceinline__ void conv_tile(const Job& jb, int tile, float* tl) {
    const int nkt = jb.Kd >> 8; const int nti = tile / nkt, kt = tile % nkt; const int n0 = nti * 64, k0 = kt * 256;
    const int sc = job_srccol(jb.mode, n0);
    const int t = tidx();
    if (sc >= 0) {
        f32x4 v[8];
#pragma unroll
        for (int q = 0; q < 8; ++q) { const int idx = t + 512 * q, k = idx >> 4, c4 = idx & 15;
            v[q] = (k0 + k < jb.Ks) ? *(const f32x4*)(jb.src + (size_t)(k0 + k) * jb.ld + sc + c4 * 4) : (f32x4){0.f, 0.f, 0.f, 0.f}; }
#pragma unroll
        for (int q = 0; q < 8; ++q) { const int idx = t + 512 * q, k = idx >> 4, c4 = idx & 15; float* d = tl + k * 65 + c4 * 4; d[0] = v[q][0]; d[1] = v[q][1]; d[2] = v[q][2]; d[3] = v[q][3]; } }
    __syncthreads();
    { const int kq = t & 7, n = t >> 3;
      if (n0 + n < jb.Nd) {
#pragma unroll
          for (int m = 0; m < 4; ++m) { const int kc = kq + 8 * m; float v[8];
#pragma unroll
              for (int i = 0; i < 8; ++i) v[i] = sc < 0 ? 0.f : tl[(kc * 8 + i) * 65 + n];
              u32x4 o; o[0] = pk2(v[0], v[1]); o[1] = pk2(v[2], v[3]); o[2] = pk2(v[4], v[5]); o[3] = pk2(v[6], v[7]);
              *(u32x4*)(jb.dst + (size_t)(n0 + n) * jb.Kd + k0 + kc * 8) = o; } } }
    __syncthreads();
}

__device__ __forceinline__ int layer_job(int l, int k) {
    const int j = l >> 1;
    if ((l & 1) == 0) { switch (k) { case 0: return j; case 1: return 2 + j; case 2: return 4 + j; case 3: return 16 + l; case 4: return 20 + l; default: return -1; } }
    switch (k) { case 0: return 6 + j; case 1: return 8 + j; case 2: return 10 + j; case 3: return 12 + j; case 4: return 14 + j; case 5: return 16 + l; case 6: return 20 + l; default: return -1; }
}
__device__ __forceinline__ void conv_layer(PRef p, int l, int wi, int nw, float* tl, int which = 0  ) {
    int tbase = 0;
    for (int k = 0; k < 7; ++k) { const int ji = layer_job(l, k); if (ji < 0) break;
        const bool is_fo = ji >= 20; if ((which == 1 && is_fo) || (which == 2 && !is_fo)) continue;
        const Job jb = get_job(p, ji); const int ntile = ((jb.Nd + 63) >> 6) * (jb.Kd >> 8);
        const int first = (wi - (tbase % nw) + nw) % nw;
        for (int tile = first; tile < ntile; tile += nw) conv_tile(jb, tile, tl);
        tbase += ntile; }
}

__device__ __forceinline__ void phase_prep(PRef p, unsigned char* shm) {
    const int t = tidx(), wg = bidx(), nwg = gdim();
    unsigned char* ws = p.ws;
    { float* X = (float*)(ws + WS_X); const f32x4* xp = (const f32x4*)p.in[0]; const f32x4* xs = (const f32x4*)p.in[1]; f32x4* X4 = (f32x4*)X;
      const size_t n4 = (size_t)T * 256, np4 = (size_t)4096 * 256;
      for (size_t i = (size_t)wg * 512 + t; i < n4; i += (size_t)nwg * 512) X4[i] = i < np4 ? xp[i] : xs[i - np4];
      bf16_t* CKV = (bf16_t*)(ws + WS_CKV); bf16_t* KPE = (bf16_t*)(ws + WS_KPE);
      for (size_t i = (size_t)wg * 512 + t; i < (size_t)2 * TK * 256; i += (size_t)nwg * 512) {
          const int j = (int)(i / ((size_t)TK * 256)); const int rem = (int)(i % ((size_t)TK * 256)); const int r = rem >> 8, c = rem & 255;
          if (c >= 128) CKV[i] = 0;
          else if (r >= T) { const int b = (r - T) >> 9, pp = (r - T) & 511; CKV[i] = f2bf(p.in[6][((size_t)(b * 2 + j) * 512 + pp) * 128 + c]); } }
      for (size_t i = (size_t)wg * 512 + t; i < (size_t)2 * 1024 * 64; i += (size_t)nwg * 512) {
          const int j = (int)(i >> 16); const int rem = (int)(i & 65535); const int rr = rem >> 6, c = rem & 63; const int b = rr >> 9, pp = rr & 511;
          KPE[((size_t)j * TK + T + rr) * 64 + c] = f2bf(p.in[7][((size_t)(b * 2 + j) * 512 + pp) * 64 + c]); } }
    float* sc = (float*)(shm + 81920);
    float* red = sc + 3072;
    {
      for (int i = t; i < 3072; i += 512) { const int ci = i >> 10, k = i & 1023; const float v = ci == 0 ? p.in[9][k] : p.in[8][(ci - 1) * 1024 + k]; sc[i] = silu_f(v); }
      __syncthreads();
      }
    auto adaln_task = [&](int task) {
          float* MOD = (float*)(ws + WS_MOD);
          const int l = task / 96, cb = task % 96; const int col = t & 63, kg = t >> 6;
          const float* w = p.in[10] + (size_t)l * 1024 * 6144 + cb * 64 + col;
          float a0 = 0.f, a1 = 0.f, a2 = 0.f;
#pragma unroll 8
          for (int k = kg * 128; k < kg * 128 + 128; ++k) { const float wv = w[(size_t)k * 6144]; a0 += sc[k] * wv; a1 += sc[1024 + k] * wv; a2 += sc[2048 + k] * wv; }
          red[(kg * 3 + 0) * 64 + col] = a0; red[(kg * 3 + 1) * 64 + col] = a1; red[(kg * 3 + 2) * 64 + col] = a2;
          __syncthreads();
          if (t < 192) { const int ci = t >> 6, c2 = t & 63; float s = p.in[11][(size_t)l * 6144 + cb * 64 + c2];
#pragma unroll
              for (int g = 0; g < 8; ++g) s += red[(g * 3 + ci) * 64 + c2];
              MOD[((size_t)l * 3 + ci) * 6144 + cb * 64 + c2] = s; }
          __syncthreads();
      };
    float* zf = (float*)shm;
    float* h1 = zf + 320;
    float* h2 = h1 + 512;
    bf16_t* GR = (bf16_t*)(ws + WS_GR);
    auto filter_task = [&](int task) {
          const int j = task / 160, tb = task % 160; const int type = tb < 32 ? 0 : 1; const int L = type ? 1024 : 256; const int pos0 = (type ? tb - 32 : tb) * 8;
          if (t < 8 * 33) { const int pi = t / 33, e = t % 33; const int idx = pos0 + pi; float v;
              if (e == 0) v = (float)idx / (float)(L - 1);
              else { const int b = (e - 1) & 15; const float f = 1e-4f + (float)b * ((15.0f - 1e-4f) / 15.0f); const float w = 6.283185307179586f * (float)idx / (float)L; v = e <= 16 ? __cosf(f * w) : -__sinf(f * w); }
              zf[pi * 40 + e] = v; }
          __syncthreads();
          { const int pi = t >> 6, u = t & 63; float s = p.in[26][j * 64 + u]; const float* w1 = p.in[25] + (size_t)j * 33 * 64 + u;
            for (int e = 0; e < 33; ++e) s += zf[pi * 40 + e] * w1[e * 64];
            h1[pi * 64 + u] = __sinf(p.in[27][j * 64 + u] * s); }
          __syncthreads();
          { const int pi = t >> 6, u = t & 63; float s = p.in[29][j * 64 + u]; const float* w2 = p.in[28] + (size_t)j * 64 * 64 + u;
            for (int e = 0; e < 64; ++e) s += h1[pi * 64 + e] * w2[e * 64];
            h2[pi * 64 + u] = __sinf(p.in[27][j * 64 + u] * s); }
          __syncthreads();
          { const float* w3 = p.in[30] + (size_t)j * 64 * 1024;
            bf16_t* gr = GR + (size_t)j * 512 * 2560 + (type ? (size_t)512 * 512 : 0);
            for (int cc = 0; cc < 2; ++cc) { const int col = t + cc * 512; float a[8];
#pragma unroll
                for (int q = 0; q < 8; ++q) a[q] = 0.f;
                for (int e = 0; e < 64; ++e) { const float wv = w3[e * 1024 + col];
#pragma unroll
                    for (int q = 0; q < 8; ++q) a[q] += h2[q * 64 + e] * wv; }
                const int ch = col & 511; const float delta = fabsf(-3.0701134573253945f + (float)ch * ((-15.350567286626973f + 3.0701134573253945f) / 511.0f));
                bf16_t* grc = gr + (size_t)ch * (2 * L);
#pragma unroll
                for (int q = 0; q < 8; ++q) { const int idx = pos0 + q; const float tp = (float)idx / (float)(L - 1); const float v = a[q] * __expf(-tp * delta);
                    if (col < 512) grc[L - 1 - idx] = f2bf(v);
                    else if (idx >= 1) grc[L - 1 + idx] = f2bf(v);
                    else grc[2 * L - 1] = 0; } } }
          __syncthreads();
      };
    { int jstart[8]; int total = 0;
#pragma unroll
      for (int k = 0; k < 7; ++k) { const int ji = layer_job(0, k); jstart[k] = total; if (ji >= 0) { const Job jb = get_job(p, ji); total += ((jb.Nd + 63) >> 6) * (jb.Kd >> 8); } }
      unsigned* q = (unsigned*)(ws + WS_BAR) + 15; volatile unsigned* slot = (volatile unsigned*)(shm + (LDS_BYTES - 32));
      for (;;) {
          if (threadIdx.x == 0) *slot = __hip_atomic_fetch_add(q, 1u, __ATOMIC_RELAXED, __HIP_MEMORY_SCOPE_AGENT);
          __syncthreads();
          const int it = (int)*slot;
          __syncthreads();
          if (it >= 704 + total) break;
          if (it < 320) filter_task(it);
          else if (it < 704) adaln_task(it - 320);
          else { const int idx = it - 704; int k = 0, base = 0;
#pragma unroll
              for (int z = 1; z < 7; ++z) if (idx >= jstart[z]) { k = z; base = jstart[z]; }
              const Job jb = get_job(p, layer_job(0, k)); conv_tile(jb, idx - base, (float*)shm); }
      } }
}

__device__ __forceinline__ void phase_norm(PRef p, int l, int which  ) {
    const int lane = tidx() & 63, wv = tidx() >> 6;
    float* X = (float*)(p.ws + WS_X); bf16_t* H = (bf16_t*)(p.ws + WS_H); const float* MOD = (const float*)(p.ws + WS_MOD); const bf16_t* P = (const bf16_t*)(p.ws + WS_P);
    const bool add = !(which == 0 && l == 0);
    const int gl = which == 1 ? l : (which == 2 ? 3 : l - 1); const int goff = which == 1 ? 2048 : 5120;
    const int stride = gdim() * 8;
    for (int rowb = bidx() * 8 + wv; rowb < T; rowb += 2 * stride) {
        f32x4 v[2][4]; float rstd[2];
#pragma unroll
        for (int u = 0; u < 2; ++u) { const int row = rowb + u * stride; if (row < T) {
            if (!add) { const f32x4* xi = (const f32x4*)(row < 4096 ? p.in[0] + (size_t)row * 1024 : p.in[1] + (size_t)(row - 4096) * 1024);
#pragma unroll
                for (int i = 0; i < 4; ++i) v[u][i] = xi[lane + 64 * i]; }
            else { const f32x4* xr = (const f32x4*)(X + (size_t)row * 1024);
#pragma unroll
                for (int i = 0; i < 4; ++i) v[u][i] = xr[lane + 64 * i]; } } }
        if (add) {
            f32x4 g[2][4]; u32x2 pa[2][4], pb[2][4];
#pragma unroll
            for (int u = 0; u < 2; ++u) { const int row = rowb + u * stride; if (row < T) { const float* gp = MOD + ((size_t)gl * 3 + cvec_of(row)) * 6144 + goff;
#pragma unroll
                for (int i = 0; i < 4; ++i) { g[u][i] = ((const f32x4*)gp)[lane + 64 * i];
                    pa[u][i] = *(const u32x2*)(P + (size_t)row * 1024 + (lane + 64 * i) * 4); pb[u][i] = *(const u32x2*)(P + (size_t)T * 1024 + (size_t)row * 1024 + (lane + 64 * i) * 4); } } }
#pragma unroll
            for (int u = 0; u < 2; ++u) { const int row = rowb + u * stride; if (row < T) {
#pragma unroll
                for (int i = 0; i < 4; ++i) { const u32x2 a = pa[u][i], b = pb[u][i]; f32x4 s4;
                    s4[0] = __uint_as_float(a[0] << 16) + __uint_as_float(b[0] << 16); s4[1] = __uint_as_float(a[0] & 0xFFFF0000u) + __uint_as_float(b[0] & 0xFFFF0000u);
                    s4[2] = __uint_as_float(a[1] << 16) + __uint_as_float(b[1] << 16); s4[3] = __uint_as_float(a[1] & 0xFFFF0000u) + __uint_as_float(b[1] & 0xFFFF0000u);
                    v[u][i] += g[u][i] * s4; } } }
        }
        f32x4 sh[2][4], sc[2][4];
#pragma unroll
        for (int u = 0; u < 2; ++u) { const int row = rowb + u * stride; if (row < T) {
            if (which == 2) {
#pragma unroll
                for (int i = 0; i < 4; ++i) sc[u][i] = ((const f32x4*)p.in[38])[lane + 64 * i]; }
            else { const float* m = MOD + ((size_t)l * 3 + cvec_of(row)) * 6144 + which * 3072;
#pragma unroll
                for (int i = 0; i < 4; ++i) { sh[u][i] = ((const f32x4*)m)[lane + 64 * i]; sc[u][i] = ((const f32x4*)(m + 1024))[lane + 64 * i]; } } } }
#pragma unroll
        for (int u = 0; u < 2; ++u) { const int row = rowb + u * stride; if (row < T) { float ss = 0.f;
#pragma unroll
            for (int i = 0; i < 4; ++i) ss += v[u][i][0] * v[u][i][0] + v[u][i][1] * v[u][i][1] + v[u][i][2] * v[u][i][2] + v[u][i][3] * v[u][i][3];
            ss = wave_sum(ss); rstd[u] = rsqrtf(ss * (1.0f / 1024.0f) + EPS); } }
#pragma unroll
        for (int u = 0; u < 2; ++u) { const int row = rowb + u * stride; if (row < T) {
            if (which != 2 || true) { if (which != 2) { f32x4* xr = (f32x4*)(X + (size_t)row * 1024);
#pragma unroll
                for (int i = 0; i < 4; ++i) xr[lane + 64 * i] = v[u][i]; } }
            if (which == 2) { float* o = p.out + (row < 4096 ? O_YP + (size_t)row * 1024 : O_YS + (size_t)(row - 4096) * 1024);
#pragma unroll
                for (int i = 0; i < 4; ++i) ((f32x4*)o)[lane + 64 * i] = v[u][i] * rstd[u] * sc[u][i]; }
            else {
#pragma unroll
                for (int i = 0; i < 4; ++i) { const f32x4 hv = v[u][i] * rstd[u] * (sc[u][i] + 1.0f) + sh[u][i]; u32x2 o; o[0] = pk2(hv[0], hv[1]); o[1] = pk2(hv[2], hv[3]);
                    *(u32x2*)(H + (size_t)row * 1024 + (lane + 64 * i) * 4) = o; } } } }
    }
}

__device__ __forceinline__ void phase_zgemm(PRef p, int j, unsigned char* shm) {
    const int t = tidx(), lane = t & 63, wv = t >> 6, r = lane & 31, h = lane >> 5;
    const bf16_t* H = (const bf16_t*)(p.ws + WS_H); const bf16_t* WZ = (const bf16_t*)(p.ws + WS_WZ) + (size_t)j * 32 * 1024; float* ZG = (float*)(p.ws + WS_ZG);
    float* red = (float*)shm;
    for (int tile = bidx(); tile < T / 32; tile += gdim()) {
        f32x16 acc = zero16();
        const bf16_t* a = H + (size_t)(tile * 32 + r) * 1024 + wv * 128 + 8 * h; const bf16_t* b = WZ + (size_t)r * 1024 + wv * 128 + 8 * h;
        bf16x8 av[8], bv[8];
#pragma unroll
        for (int ks = 0; ks < 8; ++ks) { av[ks] = *(const bf16x8*)(a + ks * 16); bv[ks] = *(const bf16x8*)(b + ks * 16); }
#pragma unroll
        for (int ks = 0; ks < 8; ++ks) acc = mfma32(av[ks], bv[ks], acc);
#pragma unroll
        for (int q = 0; q < 16; ++q) red[(wv * 16 + q) * 64 + lane] = acc[q];
        __syncthreads();
        for (int e = t; e < 1024; e += 512) { const int q = e >> 6, ln = e & 63; float s2 = 0.f;
#pragma unroll
            for (int w = 0; w < 8; ++w) s2 += red[(w * 16 + q) * 64 + ln];
            const int row = tile * 32 + (q & 3) + 8 * (q >> 2) + 4 * (ln >> 5); ZG[(size_t)row * 32 + (ln & 31)] = s2; }
        __syncthreads();
    }
}

__device__ __forceinline__ int seq_base(int s) { return s < 16 ? s * 256 : 4096 + (s - 16) * 1024; }
__device__ __forceinline__ int gla_item(int s, int h, int c, int dir) { return s < 16 ? ((s * 4 + h) * 4 + c) * 2 + dir : 512 + (((s - 16) * 4 + h) * 16 + c) * 2 + dir; }
constexpr int GLD = 72;

__device__ __forceinline__ void gla_gates(PRef p, int j, int h, int dir, int tok0, float* ZL, float* PT, float (&b)[8], float& blast) {
    const int t = tidx(), d = t & 63, g8 = t >> 6;
    const float* ZG = (const float*)(p.ws + WS_ZG);
    for (int e = t; e < 1024; e += 512) { const int ip = e >> 4, jz = e & 15; const int tok = tok0 + (dir ? 63 - ip : ip); ZL[e] = ZG[(size_t)tok * 32 + dir * 16 + jz]; }
    __syncthreads();
    const float* wg_ = p.in[dir ? 15 : 13] + (size_t)j * 16 * 256 + h * 64 + d;
    float w[16];
#pragma unroll
    for (int q = 0; q < 16; ++q) w[q] = wg_[q * 256];
    const float bias = p.in[dir ? 16 : 14][j * 256 + h * 64 + d];
    float run = 0.f;
#pragma unroll
    for (int ii = 0; ii < 8; ++ii) { const int ip = g8 * 8 + ii; float x = bias;
#pragma unroll
        for (int q = 0; q < 16; ++q) x += ZL[ip * 16 + q] * w[q];
        const float ls = fminf(x, 0.f) - log1pf(__expf(-fabsf(x)));
        run += ls * (1.0f / 16.0f); b[ii] = run; }
    PT[g8 * 64 + d] = run;
    __syncthreads();
    float off = 0.f, tot = 0.f;
#pragma unroll
    for (int g = 0; g < 8; ++g) { const float v = PT[g * 64 + d]; tot += v; if (g < g8) off += v; }
#pragma unroll
    for (int ii = 0; ii < 8; ++ii) b[ii] += off;
    blast = tot;
    __syncthreads();
}
__device__ __forceinline__ void gla_load_vt(const bf16_t* PROJ, int h, int dir, int tok0, bf16_t* VTL) {
    const int t = tidx(), e = t & 127, grp = t >> 7;
    unsigned pk[8];
#pragma unroll
    for (int q = 0; q < 8; ++q) { const int i0 = grp * 16 + 2 * q; const int tk0 = tok0 + (dir ? 63 - i0 : i0), tk1 = tok0 + (dir ? 62 - i0 : i0 + 1);
        const unsigned lo = PROJ[(size_t)tk0 * 2560 + 512 + h * 128 + e], hi = PROJ[(size_t)tk1 * 2560 + 512 + h * 128 + e]; pk[q] = lo | (hi << 16); }
    u32x4 o0, o1; o0[0] = pk[0]; o0[1] = pk[1]; o0[2] = pk[2]; o0[3] = pk[3]; o1[0] = pk[4]; o1[1] = pk[5]; o1[2] = pk[6]; o1[3] = pk[7];
    *(u32x4*)(VTL + e * GLD + grp * 16) = o0; *(u32x4*)(VTL + e * GLD + grp * 16 + 8) = o1;
}

__device__ __forceinline__ void gla_pass_a(PRef p, int j, int item, unsigned char* shm) {
    int s, h, c, dir;
    if (item < 512) { s = item >> 5; const int rem = item & 31; h = rem >> 3; c = (rem & 7) >> 1; dir = rem & 1; }
    else { const int it = item - 512; s = 16 + (it >> 7); const int rem = it & 127; h = rem >> 5; c = (rem & 31) >> 1; dir = rem & 1; }
    const int tok0 = seq_base(s) + 64 * c;
    bf16_t* KTL = (bf16_t*)shm;
    bf16_t* VTL = KTL + 64 * GLD;
    float* ZL = (float*)(VTL + 128 * GLD);
    float* PT = ZL + 1024;
    const bf16_t* PROJ = (const bf16_t*)(p.ws + WS_PROJ);
    float* DS = (float*)(p.ws + WS_DS) + (size_t)item * 8192; float* DEC = (float*)(p.ws + WS_DEC) + (size_t)item * 64;
    const int t = tidx(), d = t & 63, g8 = t >> 6;
    bf16_t kr[8];
#pragma unroll
    for (int ii = 0; ii < 8; ++ii) { const int ip = g8 * 8 + ii; const int tok = tok0 + (dir ? 63 - ip : ip); kr[ii] = PROJ[(size_t)tok * 2560 + 256 + h * 64 + d]; }
    gla_load_vt(PROJ, h, dir, tok0, VTL);
    float b[8], blast;
    gla_gates(p, j, h, dir, tok0, ZL, PT, b, blast);
    { unsigned pk[4];
#pragma unroll
      for (int q = 0; q < 4; ++q) pk[q] = pk2(bf2f(kr[2 * q]) * __expf(blast - b[2 * q]), bf2f(kr[2 * q + 1]) * __expf(blast - b[2 * q + 1]));
      u32x4 o; o[0] = pk[0]; o[1] = pk[1]; o[2] = pk[2]; o[3] = pk[3];
      *(u32x4*)(KTL + d * GLD + g8 * 8) = o; }
    if (t < 64) DEC[t] = __expf(blast);
    __syncthreads();
    { const int wv = t >> 6, lane = t & 63, mt = wv >> 2, nt = wv & 3, hh = lane >> 5, r = lane & 31;
      f32x16 acc = mma_rows(KTL + mt * 32 * GLD, GLD, VTL + nt * 32 * GLD, GLD, 64, zero16());
#pragma unroll
      for (int q = 0; q < 16; ++q) { const int dd = 32 * mt + (q & 3) + 8 * (q >> 2) + 4 * hh; DS[dd * 128 + 32 * nt + r] = acc[q]; } }
    __syncthreads();
}

__device__ __forceinline__ void gla_pass_b(PRef p, int j, int item, unsigned char* shm) {
    int s, h, c, nC;
    if (item < 256) { s = item >> 4; h = (item >> 2) & 3; c = item & 3; nC = 4; }
    else { const int it = item - 256; s = 16 + (it >> 6); h = (it >> 4) & 3; c = it & 15; nC = 16; }
    const int tok0 = seq_base(s) + 64 * c;
    float* OL = (float*)shm;
    bf16_t* QL = (bf16_t*)(OL + 64 * 132);
    bf16_t* KL = QL + 64 * GLD;
    bf16_t* PL = KL + 64 * GLD;
    bf16_t* VTL = PL + 64 * GLD;
    bf16_t* STL = VTL + 128 * GLD;
    float* ZL = (float*)(STL + 128 * GLD);
    float* PT = ZL + 1024;
    const bf16_t* PROJ = (const bf16_t*)(p.ws + WS_PROJ);
    const float* DSb = (const float*)(p.ws + WS_DS); const float* DECb = (const float*)(p.ws + WS_DEC);
    const int t = tidx(), d = t & 63, g8 = t >> 6, wv = t >> 6, lane = t & 63;
    bf16_t ra0[8], ra1[8];
#pragma unroll
    for (int q = 0; q < 8; ++q) { const int tok = tok0 + wv * 8 + q; ra0[q] = PROJ[(size_t)tok * 2560 + 1024 + h * 128 + lane]; ra1[q] = PROJ[(size_t)tok * 2560 + 1024 + h * 128 + 64 + lane]; }
    for (int dir = 0; dir < 2; ++dir) {
        bf16_t qr[8], kr[8];
#pragma unroll
        for (int ii = 0; ii < 8; ++ii) { const int ip = g8 * 8 + ii; const int tok = tok0 + (dir ? 63 - ip : ip);
            qr[ii] = PROJ[(size_t)tok * 2560 + h * 64 + d]; kr[ii] = PROJ[(size_t)tok * 2560 + 256 + h * 64 + d]; }
        gla_load_vt(PROJ, h, dir, tok0, VTL);
        { const int e = t & 127, dg = t >> 7; float S[16];
          if (s >= 16) { const float* st = p.in[dir ? 3 : 2] + ((size_t)((s - 16) * 2 + j) * 4 + h) * 8192;
#pragma unroll
              for (int i = 0; i < 16; ++i) S[i] = st[(dg * 16 + i) * 128 + e]; }
          else {
#pragma unroll
              for (int i = 0; i < 16; ++i) S[i] = 0.f; }
          const int nprev = dir ? nC - 1 - c : c;
#pragma unroll 2
          for (int q = 0; q < nprev; ++q) { const int cc = dir ? nC - 1 - q : q; const int it = gla_item(s, h, cc, dir);
              const float* ds = DSb + (size_t)it * 8192 + (size_t)(dg * 16) * 128 + e; const f32x4* dc4 = (const f32x4*)(DECb + (size_t)it * 64 + dg * 16);
              float dv[16]; f32x4 dcv[4];
#pragma unroll
              for (int i = 0; i < 4; ++i) dcv[i] = dc4[i];
#pragma unroll
              for (int i = 0; i < 16; ++i) dv[i] = ds[i * 128];
#pragma unroll
              for (int i = 0; i < 16; ++i) S[i] = S[i] * dcv[i >> 2][i & 3] + dv[i]; }
          u32x4 o0, o1;
          o0[0] = pk2(S[0], S[1]); o0[1] = pk2(S[2], S[3]); o0[2] = pk2(S[4], S[5]); o0[3] = pk2(S[6], S[7]);
          o1[0] = pk2(S[8], S[9]); o1[1] = pk2(S[10], S[11]); o1[2] = pk2(S[12], S[13]); o1[3] = pk2(S[14], S[15]);
          *(u32x4*)(STL + e * GLD + dg * 16) = o0; *(u32x4*)(STL + e * GLD + dg * 16 + 8) = o1;
          if (s < 16 && ((dir == 0 && c == nC - 1) || (dir == 1 && c == 0))) {
              const int it = gla_item(s, h, c, dir); const float* ds = DSb + (size_t)it * 8192; const float* dc = DECb + (size_t)it * 64;
              float* o = p.out + (dir ? O_SB : O_SF) + ((size_t)(s * 2 + j) * 4 + h) * 8192;
#pragma unroll
              for (int i = 0; i < 16; ++i) o[(dg * 16 + i) * 128 + e] = S[i] * dc[dg * 16 + i] + ds[(dg * 16 + i) * 128 + e]; } }
        float b[8], blast;
        gla_gates(p, j, h, dir, tok0, ZL, PT, b, blast);
#pragma unroll
        for (int ii = 0; ii < 8; ++ii) { const int ip = g8 * 8 + ii;
            const float qv = bf2f(qr[ii]) * 0.125f * __expf(b[ii]);
            const float kv = bf2f(kr[ii]) * __expf(-b[ii]);
            QL[ip * GLD + d] = f2bf(qv); KL[ip * GLD + d] = f2bf(kv); }
        __syncthreads();
        const int hh = lane >> 5, r = lane & 31;
        if (wv < 4) { const int mt = wv >> 1, nt = wv & 1;
            f32x16 sc = mma_rows(QL + mt * 32 * GLD, GLD, KL + nt * 32 * GLD, GLD, 64, zero16());
#pragma unroll
            for (int q = 0; q < 16; ++q) { const int ip = 32 * mt + (q & 3) + 8 * (q >> 2) + 4 * hh, jp = 32 * nt + r; PL[ip * GLD + jp] = f2bf(jp <= ip ? sc[q] : 0.f); } }
        const int mt = wv >> 2, nt = wv & 3;
        f32x16 acc = mma_rows(QL + mt * 32 * GLD, GLD, STL + nt * 32 * GLD, GLD, 64, zero16());
        __syncthreads();
        acc = mma_rows(PL + mt * 32 * GLD, GLD, VTL + nt * 32 * GLD, GLD, 64, acc);
#pragma unroll
        for (int q = 0; q < 16; ++q) { const int ip = 32 * mt + (q & 3) + 8 * (q >> 2) + 4 * hh; const int pp = dir ? 63 - ip : ip; float* o = OL + pp * 132 + 32 * nt + r;
            if (dir == 0) *o = acc[q]; else *o += acc[q]; }
        __syncthreads();
    }
    bf16_t* MIX = (bf16_t*)(p.ws + WS_MIX);
    const float g0 = p.in[17][j * 128 + lane], g1 = p.in[17][j * 128 + 64 + lane];
#pragma unroll
    for (int q = 0; q < 8; ++q) { const int pp = wv * 8 + q; const int tok = tok0 + pp;
        const float v0 = OL[pp * 132 + lane], v1 = OL[pp * 132 + 64 + lane];
        const float ss = wave_sum(v0 * v0 + v1 * v1); const float rstd = rsqrtf(ss * (1.0f / 128.0f) + EPS);
        const float r0 = bf2f(ra0[q]), r1 = bf2f(ra1[q]);
        MIX[(size_t)tok * 1024 + h * 128 + lane] = f2bf(v0 * rstd * g0 * silu_f(r0));
        MIX[(size_t)tok * 1024 + h * 128 + 64 + lane] = f2bf(v1 * rstd * g1 * silu_f(r1)); }
    __syncthreads();
}

__device__ __forceinline__ void gqa_prep(PRef p, int j, int rb, unsigned char* shm) {
    const int t = tidx(), lane = t & 63, wv = t >> 6;
    const int r0 = rb * 64;
    const bf16_t* PROJ = (const bf16_t*)(p.ws + WS_PROJ);
    bf16_t* QNG = (bf16_t*)(p.ws + WS_QNG); bf16_t* KNG = (bf16_t*)(p.ws + WS_KNG); bf16_t* VTG = (bf16_t*)(p.ws + WS_VTG);
    bf16_t* VL = (bf16_t*)shm;
    const bool ctx = r0 >= T;
    if (!ctx) {
        const float gq0 = p.in[18][j * 128 + lane], gq1 = p.in[18][j * 128 + 64 + lane], gk0 = p.in[19][j * 128 + lane], gk1 = p.in[19][j * 128 + 64 + lane];
        const float inv = exp2f(-(float)(lane & 31) * (13.287712379549449f / 32.0f));
        for (int hb = 0; hb < 6; ++hb) {
            bf16_t r1[8], r2[8];
#pragma unroll
            for (int u = 0; u < 8; ++u) { const int hv = wv * 48 + hb * 8 + u; const int row = r0 + hv / 6, which = hv % 6; const int col = which < 4 ? 1536 + which * 128 : 2048 + (which - 4) * 128;
                r1[u] = PROJ[(size_t)row * 2560 + col + lane]; r2[u] = PROJ[(size_t)row * 2560 + col + 64 + lane]; }
#pragma unroll
            for (int u = 0; u < 8; ++u) { const int hv = wv * 48 + hb * 8 + u; const int row = r0 + hv / 6, which = hv % 6;
                float x1 = bf2f(r1[u]), x2 = bf2f(r2[u]);
                const float ss = wave_sum(x1 * x1 + x2 * x2); const float rstd = rsqrtf(ss * (1.0f / 128.0f) + EPS);
                x1 = x1 * rstd * (which < 4 ? gq0 : gk0); x2 = x2 * rstd * (which < 4 ? gq1 : gk1);
                if (row < 4096) {
                    if (which >= 4) { const int b = row >> 8, tt = row & 255; float* o = p.out + O_CK + ((size_t)(b * 2 + j) * 256 + tt) * 256 + (which - 4) * 128; o[lane] = x1; o[64 + lane] = x2; }
                } else { const int tt = (row - 4096) & 1023; const float pos = lane < 32 ? (float)(tt >> 6) : (float)(tt & 63); const float ang = pos * inv;
                    const float cs = __cosf(ang), sn = __sinf(ang); const float y1 = x1 * cs - x2 * sn, y2 = x1 * sn + x2 * cs; x1 = y1; x2 = y2; }
                if (which < 4) { QNG[(size_t)row * 512 + which * 128 + lane] = f2bf(x1); QNG[(size_t)row * 512 + which * 128 + 64 + lane] = f2bf(x2); }
                else { KNG[(size_t)row * 256 + (which - 4) * 128 + lane] = f2bf(x1); KNG[(size_t)row * 256 + (which - 4) * 128 + 64 + lane] = f2bf(x2); } } }
        { u32x4 vv[4];
#pragma unroll
          for (int i = 0; i < 4; ++i) { const int c = t + 512 * i, rr = c >> 5, piece = c & 31; vv[i] = *(const u32x4*)(PROJ + (size_t)(r0 + rr) * 2560 + 2304 + piece * 8); }
#pragma unroll
          for (int i = 0; i < 4; ++i) { const int c = t + 512 * i, rr = c >> 5, piece = c & 31; const int row = r0 + rr;
              *(u32x4*)(VL + rr * 264 + piece * 8) = vv[i];
              if (row < 4096) { const int b = row >> 8, tt = row & 255; float* o = p.out + O_CV + ((size_t)(b * 2 + j) * 256 + tt) * 256 + piece * 8;
                  f32x4 o0, o1; o0[0] = __uint_as_float(vv[i][0] << 16); o0[1] = __uint_as_float(vv[i][0] & 0xFFFF0000u); o0[2] = __uint_as_float(vv[i][1] << 16); o0[3] = __uint_as_float(vv[i][1] & 0xFFFF0000u);
                  o1[0] = __uint_as_float(vv[i][2] << 16); o1[1] = __uint_as_float(vv[i][2] & 0xFFFF0000u); o1[2] = __uint_as_float(vv[i][3] << 16); o1[3] = __uint_as_float(vv[i][3] & 0xFFFF0000u);
                  *(f32x4*)o = o0; *(f32x4*)(o + 4) = o1; } } }
    } else {
        f32x4 kk[4][2], vv[4][2];
#pragma unroll
        for (int i = 0; i < 4; ++i) { const int c = t + 512 * i, rr = c >> 5, piece = c & 31; const int row = r0 + rr; const int b = (row - T) >> 9, pp = (row - T) & 511;
            const size_t ci = ((size_t)(b * 2 + j) * 512 + pp) * 256 + piece * 8;
            kk[i][0] = *(const f32x4*)(p.in[4] + ci); kk[i][1] = *(const f32x4*)(p.in[4] + ci + 4); vv[i][0] = *(const f32x4*)(p.in[5] + ci); vv[i][1] = *(const f32x4*)(p.in[5] + ci + 4); }
#pragma unroll
        for (int i = 0; i < 4; ++i) { const int c = t + 512 * i, rr = c >> 5, piece = c & 31; const int row = r0 + rr;
            u32x4 ko, vo; ko[0] = pk2(kk[i][0][0], kk[i][0][1]); ko[1] = pk2(kk[i][0][2], kk[i][0][3]); ko[2] = pk2(kk[i][1][0], kk[i][1][1]); ko[3] = pk2(kk[i][1][2], kk[i][1][3]);
            vo[0] = pk2(vv[i][0][0], vv[i][0][1]); vo[1] = pk2(vv[i][0][2], vv[i][0][3]); vo[2] = pk2(vv[i][1][0], vv[i][1][1]); vo[3] = pk2(vv[i][1][2], vv[i][1][3]);
            *(u32x4*)(KNG + (size_t)row * 256 + piece * 8) = ko; *(u32x4*)(VL + rr * 264 + piece * 8) = vo; }
    }
    __syncthreads();
    { const int gd = t & 255, half = t >> 8; unsigned pk[16];
#pragma unroll
      for (int q = 0; q < 16; ++q) { const unsigned lo = VL[(half * 32 + 2 * q) * 264 + gd], hi = VL[(half * 32 + 2 * q + 1) * 264 + gd]; pk[q] = lo | (hi << 16); }
      bf16_t* dst = VTG + (size_t)gd * TK + r0 + half * 32;
#pragma unroll
      for (int q = 0; q < 4; ++q) { u32x4 o; o[0] = pk[4 * q]; o[1] = pk[4 * q + 1]; o[2] = pk[4 * q + 2]; o[3] = pk[4 * q + 3]; *(u32x4*)(dst + 8 * q) = o; } }
    __syncthreads();
}

template <int KS1, int KS2>
__device__ __forceinline__ void attn_wg(const bf16_t* K1, int ld1, const bf16_t* K2, int ld2, const bf16x8 (&bq)[KS1 + KS2], const bf16_t* VT, int ldvt,
                                        int seg0_base, int seg0_tiles, int seg1_base, int tpq, float sc2, bf16_t* out, int ldo, unsigned char* shm) {
    constexpr int KLD = (KS1 + KS2) * 16 + 8, VLD = 36, KTILE = 32 * KLD, VTILE = 128 * VLD;
    bf16_t* Kl = (bf16_t*)shm; bf16_t* Vl = Kl + 4 * KTILE;
    const int t = tidx(), wv = t >> 6, lane = t & 63, r = lane & 31, h = lane >> 5, qblk = wv & 1, kq = wv >> 1;
    f32x16 oacc[4];
#pragma unroll
    for (int i = 0; i < 4; ++i) oacc[i] = zero16();
    float m = -1e30f, l = 0.f;
    u32x4 rk1[4], rk2[2], rv[4];
#define ATT_KB(q_, st_) ({ const int Tt_ = (q_) * tpq + (st_); Tt_ < seg0_tiles ? seg0_base + 32 * Tt_ : seg1_base + 32 * (Tt_ - seg0_tiles); })
#define ATT_LOAD(st_) do { \
        _Pragma("unroll") for (int i_ = 0; i_ < 4; ++i_) { const int kb_ = ATT_KB(i_, st_); \
            rk1[i_] = *(const u32x4*)(K1 + (size_t)(kb_ + (t >> 4)) * ld1 + (t & 15) * 8); \
            rv[i_] = *(const u32x4*)(VT + (size_t)(t >> 2) * ldvt + kb_ + (t & 3) * 8); } \
        if (KS2 > 0) { _Pragma("unroll") for (int i_ = 0; i_ < 2; ++i_) { const int kb_ = ATT_KB((t >> 8) + 2 * i_, st_); \
            rk2[i_] = *(const u32x4*)(K2 + (size_t)(kb_ + ((t & 255) >> 3)) * ld2 + (t & 7) * 8); } } } while (0)
    ATT_LOAD(0);
    for (int st = 0; st < tpq; ++st) {
#pragma unroll
        for (int i = 0; i < 4; ++i) { *(u32x4*)(Kl + i * KTILE + (t >> 4) * KLD + (t & 15) * 8) = rk1[i];
            bf16_t* vd = Vl + i * VTILE + (t >> 2) * VLD + (t & 3) * 8; u32x2 a, b; a[0] = rv[i][0]; a[1] = rv[i][1]; b[0] = rv[i][2]; b[1] = rv[i][3]; *(u32x2*)vd = a; *(u32x2*)(vd + 4) = b; }
        if (KS2 > 0) {
#pragma unroll
            for (int i = 0; i < 2; ++i) *(u32x4*)(Kl + ((t >> 8) + 2 * i) * KTILE + ((t & 255) >> 3) * KLD + KS1 * 16 + (t & 7) * 8) = rk2[i]; }
        __syncthreads();
        if (st + 1 < tpq) ATT_LOAD(st + 1);
        f32x16 s = zero16();
        { const bf16_t* kp = Kl + kq * KTILE + r * KLD + 8 * h;
#pragma unroll
          for (int ks = 0; ks < KS1 + KS2; ++ks) s = mfma32(*(const bf16x8*)(kp + ks * 16), bq[ks], s); }
        float tmax = s[0];
#pragma unroll
        for (int q = 1; q < 16; ++q) tmax = fmaxf(tmax, s[q]);
        tmax = fmaxf(tmax, __shfl_xor(tmax, 32, 64));
        const float mnew = fmaxf(m, tmax); const float alpha = __builtin_amdgcn_exp2f((m - mnew) * sc2); const float mb = mnew * sc2;
        float pr[16]; float rs = 0.f;
#pragma unroll
        for (int q = 0; q < 16; ++q) { pr[q] = __builtin_amdgcn_exp2f(s[q] * sc2 - mb); rs += pr[q]; }
        l = l * alpha + rs; m = mnew;
#pragma unroll
        for (int i = 0; i < 4; ++i) oacc[i] *= alpha;
        bf16x8 pb[2];
#pragma unroll
        for (int si = 0; si < 2; ++si) { u32x4 w; w[0] = pk2(pr[8 * si], pr[8 * si + 1]); w[1] = pk2(pr[8 * si + 2], pr[8 * si + 3]); w[2] = pk2(pr[8 * si + 4], pr[8 * si + 5]); w[3] = pk2(pr[8 * si + 6], pr[8 * si + 7]);
            pb[si] = __builtin_bit_cast(bf16x8, w); }
#pragma unroll
        for (int dt = 0; dt < 4; ++dt) { const bf16_t* vp = Vl + kq * VTILE + (dt * 32 + r) * VLD + 4 * h;
#pragma unroll
            for (int si = 0; si < 2; ++si) { const u32x2 lo = *(const u32x2*)(vp + 16 * si), hi = *(const u32x2*)(vp + 16 * si + 8);
                u32x4 w; w[0] = lo[0]; w[1] = lo[1]; w[2] = hi[0]; w[3] = hi[1];
                oacc[dt] = mfma32(__builtin_bit_cast(bf16x8, w), pb[si], oacc[dt]); } }
        __syncthreads();
    }
#undef ATT_LOAD
#undef ATT_KB
    float* OC = (float*)shm;
    float* ML = OC + 8 * 64 * 64;
    const float ltot = l + __shfl_xor(l, 32, 64);
    ML[(wv * 2 + 0) * 64 + lane] = m; ML[(wv * 2 + 1) * 64 + lane] = ltot;
    { float* oc = OC + (size_t)wv * 4096 + lane;
#pragma unroll
      for (int dt = 0; dt < 4; ++dt)
#pragma unroll
          for (int q = 0; q < 16; ++q) oc[(dt * 16 + q) * 64] = oacc[dt][q]; }
    __syncthreads();
    { float mk[4], lk[4]; float M = -1e30f;
#pragma unroll
      for (int k = 0; k < 4; ++k) { mk[k] = ML[((k * 2 + qblk) * 2 + 0) * 64 + lane]; lk[k] = ML[((k * 2 + qblk) * 2 + 1) * 64 + lane]; M = fmaxf(M, mk[k]); }
      float sk[4]; float L = 0.f;
#pragma unroll
      for (int k = 0; k < 4; ++k) { sk[k] = __builtin_amdgcn_exp2f((mk[k] - M) * sc2); L += sk[k] * lk[k]; }
      const float inv = 1.0f / L; const int dt = kq;
      float o[16];
#pragma unroll
      for (int q = 0; q < 16; ++q) { float v = 0.f;
#pragma unroll
          for (int k = 0; k < 4; ++k) v += sk[k] * OC[(size_t)(k * 2 + qblk) * 4096 + (dt * 16 + q) * 64 + lane];
          o[q] = v * inv; }
#pragma unroll
      for (int rg = 0; rg < 4; ++rg) { u32x2 w; w[0] = pk2(o[4 * rg], o[4 * rg + 1]); w[1] = pk2(o[4 * rg + 2], o[4 * rg + 3]);
          *(u32x2*)(out + (size_t)(qblk * 32 + r) * ldo + dt * 32 + 8 * rg + 4 * h) = w; } }
    __syncthreads();
}

__device__ __forceinline__ void gqa_attn_item(PRef p, int a, unsigned char* shm) {
    const int wv = tidx() >> 6, lane = tidx() & 63, r = lane & 31, h = lane >> 5;
    int hq, q0, s0b, s0t, s1b, tpq;
    if (a < 128) { const int b = a >> 6; hq = (a >> 4) & 3; const int qb = a & 15; q0 = 4096 + b * 1024 + qb * 64; s0b = T + b * 512; s0t = 16; s1b = 4096 + b * 1024; tpq = 12; }
    else { const int aa = a - 128; const int b = aa >> 4; hq = (aa >> 2) & 3; const int qb = aa & 3; q0 = b * 256 + qb * 64; s0b = b * 256; s0t = 8; s1b = 0; tpq = 2; }
    const int g = hq >> 1;
    const bf16_t* QNG = (const bf16_t*)(p.ws + WS_QNG); const bf16_t* KNG = (const bf16_t*)(p.ws + WS_KNG); const bf16_t* VTG = (const bf16_t*)(p.ws + WS_VTG);
    bf16_t* MIX = (bf16_t*)(p.ws + WS_MIX);
    bf16x8 bq[8];
    const bf16_t* qp = QNG + (size_t)(q0 + (wv & 1) * 32 + r) * 512 + hq * 128 + 8 * h;
#pragma unroll
    for (int ks = 0; ks < 8; ++ks) bq[ks] = *(const bf16x8*)(qp + ks * 16);
    attn_wg<8, 0>(KNG + g * 128, 256, nullptr, 0, bq, VTG + (size_t)g * 128 * TK, TK, s0b, s0t, s1b, tpq, 0.08838834764831845f * 1.4426950408889634f,
                  MIX + (size_t)q0 * 1024 + 512 + hq * 128, 1024, shm);
}
__device__ __forceinline__ void mla_attn_item(PRef p, int j, int a, unsigned char* shm) {
    const int wv = tidx() >> 6, lane = tidx() & 63, r = lane & 31, h = lane >> 5;
    int hd, q0, s0b, s0t, s1b, tpq; bool samp;
    if (a < 128) { const int b = a >> 6; hd = (a >> 4) & 3; const int qb = a & 15; q0 = 4096 + b * 1024 + qb * 64; s0b = T + b * 512; s0t = 16; s1b = 4096 + b * 1024; tpq = 12; samp = true; }
    else { const int aa = a - 128; const int b = aa >> 4; hd = (aa >> 2) & 3; const int qb = aa & 3; q0 = b * 256 + qb * 64; s0b = b * 256; s0t = 8; s1b = 0; tpq = 2; samp = false; }
    const bf16_t* QM = (const bf16_t*)(p.ws + WS_QMLA); const bf16_t* KN = (const bf16_t*)(p.ws + WS_KNOPE); const bf16_t* KPE = (const bf16_t*)(p.ws + WS_KPE) + (size_t)j * TK * 64;
    const bf16_t* VTM = (const bf16_t*)(p.ws + WS_VTM); bf16_t* MIX = (bf16_t*)(p.ws + WS_MIX);
    bf16x8 bq[12];
    const int qrow = q0 + (wv & 1) * 32 + r;
    const bf16_t* qp = QM + (size_t)qrow * 768 + hd * 192 + 8 * h;
#pragma unroll
    for (int ks = 0; ks < 12; ++ks) bq[ks] = *(const bf16x8*)(qp + ks * 16);
    if (samp) { const int tt = (qrow - 4096) & 1023; const float prow = (float)(tt >> 6), pcol = (float)(tt & 63);
#pragma unroll
        for (int ksp = 0; ksp < 2; ++ksp) { bf16x8 x1 = bq[8 + ksp], x2 = bq[10 + ksp];
#pragma unroll
            for (int jj = 0; jj < 8; ++jj) { const int i = 16 * ksp + 8 * h + jj; const float inv = exp2f(-(float)(i & 15) * (13.287712379549449f / 16.0f)); const float ang = (i < 16 ? prow : pcol) * inv;
                const float cs = __cosf(ang), sn = __sinf(ang); const float a1 = bf2f((bf16_t)x1[jj]), a2 = bf2f((bf16_t)x2[jj]);
                x1[jj] = (short)f2bf(a1 * cs - a2 * sn); x2[jj] = (short)f2bf(a1 * sn + a2 * cs); }
            bq[8 + ksp] = x1; bq[10 + ksp] = x2; } }
    attn_wg<8, 4>(KN + hd * 128, 512, KPE, 64, bq, VTM + (size_t)hd * 128 * TK, TK, s0b, s0t, s1b, tpq, 0.07216878364870322f * 1.4426950408889634f,
                  MIX + (size_t)q0 * 1024 + 512 + hd * 128, 1024, shm);
}

__device__ __forceinline__ void odd_prep(PRef p, int j, int rb, unsigned char* shm) {
    const int t = tidx(), lane = t & 63, wv = t >> 6; const int r0 = rb * 16;
    const bf16_t* PROJ = (const bf16_t*)(p.ws + WS_PROJ);
    bf16_t* X0 = (bf16_t*)(p.ws + WS_X0); bf16_t* GV = (bf16_t*)(p.ws + WS_GV); bf16_t* GVT = (bf16_t*)(p.ws + WS_GVT);
    bf16_t* GL = (bf16_t*)shm;
    { const int ch = t; float w[3][3], bb[3];
      const int L = r0 < 4096 ? 256 : 1024; const int tt0 = r0 < 4096 ? (r0 & 255) : ((r0 - 4096) & 1023);
      bf16_t u[3][18];
#pragma unroll
      for (int part = 0; part < 3; ++part) { bb[part] = p.in[23][j * 1536 + part * 512 + ch];
#pragma unroll
          for (int tap = 0; tap < 3; ++tap) w[part][tap] = p.in[22][((size_t)j * 3 + tap) * 1536 + part * 512 + ch];
#pragma unroll
          for (int q = 0; q < 18; ++q) { const bool ok = (q == 0) ? (tt0 > 0) : ((q == 17) ? (tt0 + 16 < L) : true);
              u[part][q] = ok ? PROJ[(size_t)(r0 - 1 + q) * 2048 + part * 512 + ch] : (bf16_t)0; } }
#pragma unroll
      for (int rr = 0; rr < 16; ++rr) { const int row = r0 + rr;
          float o[3];
#pragma unroll
          for (int part = 0; part < 3; ++part) o[part] = bf2f(u[part][rr]) * w[part][0] + bf2f(u[part][rr + 1]) * w[part][1] + bf2f(u[part][rr + 2]) * w[part][2] + bb[part];
          const bf16_t gvb = f2bf(o[1] * o[2]);
          X0[(size_t)row * 512 + ch] = f2bf(o[0]); GV[(size_t)row * 512 + ch] = gvb; GL[rr * 520 + ch] = gvb; } }
    __syncthreads();
    { const int ch = t; bf16_t* dst = GVT + (size_t)ch * T + r0;
#pragma unroll
      for (int q = 0; q < 2; ++q) { u32x4 o;
#pragma unroll
          for (int z = 0; z < 4; ++z) { const unsigned lo = GL[(8 * q + 2 * z) * 520 + ch], hi = GL[(8 * q + 2 * z + 1) * 520 + ch]; o[z] = lo | (hi << 16); }
          *(u32x4*)(dst + 8 * q) = o; } }
    bf16_t* CQN = (bf16_t*)(p.ws + WS_CQN); bf16_t* CKV = (bf16_t*)(p.ws + WS_CKV) + (size_t)j * TK * 256; bf16_t* KPE = (bf16_t*)(p.ws + WS_KPE) + (size_t)j * TK * 64;
    for (int rr = wv; rr < 16; rr += 8) { const int row = r0 + rr; const bf16_t* pr = PROJ + (size_t)row * 2048;
        { float v[4]; float ss = 0.f;
#pragma unroll
          for (int q = 0; q < 4; ++q) { v[q] = bf2f(pr[1536 + lane * 4 + q]); ss += v[q] * v[q]; }
          ss = wave_sum(ss); const float rstd = rsqrtf(ss * (1.0f / 256.0f) + EPS); const f32x4 g = *(const f32x4*)(p.in[31] + j * 256 + lane * 4);
          u32x2 o; o[0] = pk2(v[0] * rstd * g[0], v[1] * rstd * g[1]); o[1] = pk2(v[2] * rstd * g[2], v[3] * rstd * g[3]);
          *(u32x2*)(CQN + (size_t)row * 256 + lane * 4) = o; }
        { float v0 = bf2f(pr[1792 + lane * 2]), v1 = bf2f(pr[1792 + lane * 2 + 1]); const float ss = wave_sum(v0 * v0 + v1 * v1); const float rstd = rsqrtf(ss * (1.0f / 128.0f) + EPS);
          v0 = v0 * rstd * p.in[33][j * 128 + lane * 2]; v1 = v1 * rstd * p.in[33][j * 128 + lane * 2 + 1];
          *(unsigned*)(CKV + (size_t)row * 256 + lane * 2) = pk2(v0, v1);
          if (row < 4096) { const int b = row >> 8, tt = row & 255; float* o = p.out + O_CKV + ((size_t)(b * 2 + j) * 256 + tt) * 128 + lane * 2; o[0] = v0; o[1] = v1; } }
        { float v = bf2f(pr[1920 + lane]);
          if (row < 4096) { const int b = row >> 8, tt = row & 255; p.out[O_KPE + ((size_t)(b * 2 + j) * 256 + tt) * 64 + lane] = v; }
          else { const int tt = (row - 4096) & 1023; const float other = __shfl_xor(v, 32, 64); const int i = lane & 31;
              const float inv = exp2f(-(float)(i & 15) * (13.287712379549449f / 16.0f)); const float ang = (i < 16 ? (float)(tt >> 6) : (float)(tt & 63)) * inv; const float cs = __cosf(ang), sn = __sinf(ang);
              v = lane < 32 ? v * cs - other * sn : other * sn + v * cs; }
          KPE[(size_t)row * 64 + lane] = f2bf(v); } }
    __syncthreads();
}

__device__ __forceinline__ void hyena_conv(PRef p, int j, int type, int half, int cg8, unsigned char* shm) {
    const int t = tidx(), lane = t & 63, wv = t >> 6, r = lane & 31, h = lane >> 5;
    const int L = type ? 1024 : 256, nb = L >> 5, tbase = type ? 4096 : half * 2048;
    bf16_t* OUT = (bf16_t*)shm;
    bf16_t* GRL = (bf16_t*)(shm + 32768) + wv * 2048;
    bf16_t* GVL = (bf16_t*)(shm + 65536) + wv * 2048;
    bf16_t* ZR = (bf16_t*)(shm + 98304);
    const int ch = cg8 * 8 + wv;
    const bf16_t* gr = (const bf16_t*)(p.ws + WS_GR) + (size_t)j * 512 * 2560 + (type ? (size_t)512 * 512 : 0) + (size_t)ch * (2 * L);
    for (int i = lane; i < (2 * L) / 8; i += 64) *(u32x4*)(GRL + i * 8) = *(const u32x4*)(gr + i * 8);
    const bf16_t* gvt = (const bf16_t*)(p.ws + WS_GVT) + (size_t)ch * T + tbase;
    for (int i = lane; i < 256; i += 64) *(u32x4*)(GVL + i * 8) = *(const u32x4*)(gvt + i * 8);
    if (t < 8) ((unsigned*)ZR)[t] = 0u;
    __syncthreads();
    f32x16 acc[2];
    acc[0] = zero16(); acc[1] = zero16();
    int cola[2], colb[2];
#pragma unroll
    for (int nt = 0; nt < 2; ++nt) { const int n = 32 * nt + r; const int batch = n / nb, a = n % nb; cola[nt] = a; colb[nt] = batch * L + 8 * h; }
    for (int dl = -(nb - 1); dl <= nb - 1; ++dl) {
#pragma unroll
        for (int kk = 0; kk < 2; ++kk) {
            const int m0 = (L - 1) - (32 * dl + r - 16 * kk - 8 * h);
            bf16x8 af;
#pragma unroll
            for (int jj = 0; jj < 8; ++jj) af[jj] = (short)((const volatile LAS bf16_t*)(LAS bf16_t*)GRL)[m0 + jj];
#pragma unroll
            for (int nt = 0; nt < 2; ++nt) { const int ab = cola[nt] - dl;
                const bf16_t* bp = (ab >= 0 && ab < nb) ? GVL + colb[nt] + 32 * ab + 16 * kk : ZR;
                acc[nt] = mfma32(af, *(const bf16x8*)bp, acc[nt]); }
        }
    }
#pragma unroll
    for (int nt = 0; nt < 2; ++nt) { const int n = 32 * nt + r; const int batch = n / nb, a = n % nb;
#pragma unroll
        for (int q = 0; q < 16; ++q) { const int i = (q & 3) + 8 * (q >> 2) + 4 * h; OUT[(batch * L + 32 * a + i) * 8 + wv] = f2bf(acc[nt][q]); } }
    __syncthreads();
    const bf16_t* X0 = (const bf16_t*)(p.ws + WS_X0); const bf16_t* GV = (const bf16_t*)(p.ws + WS_GV); bf16_t* MIX = (bf16_t*)(p.ws + WS_MIX);
    float sk[8];
#pragma unroll
    for (int q = 0; q < 8; ++q) sk[q] = p.in[24][j * 512 + cg8 * 8 + q];
    for (int tl = t; tl < 2048; tl += 512) { const int row = tbase + tl;
        const bf16x8 y = *(const bf16x8*)(OUT + tl * 8), x0 = *(const bf16x8*)(X0 + (size_t)row * 512 + cg8 * 8), gv = *(const bf16x8*)(GV + (size_t)row * 512 + cg8 * 8);
        float o[8];
#pragma unroll
        for (int q = 0; q < 8; ++q) o[q] = bf2f((bf16_t)x0[q]) * (bf2f((bf16_t)y[q]) + bf2f((bf16_t)gv[q]) * sk[q]);
        u32x4 w; w[0] = pk2(o[0], o[1]); w[1] = pk2(o[2], o[3]); w[2] = pk2(o[4], o[5]); w[3] = pk2(o[6], o[7]);
        *(u32x4*)(MIX + (size_t)row * 1024 + cg8 * 8) = w; }
    __syncthreads();
}

#define XB_TMO      128
#define XB_XCNT(j)  (256  + 64 * (j))
#define XB_XSUB(j)  (1280 + 64 * (j))
#define XB_XGEN(j)  (2304 + 64 * (j))
#define XB_TOP      3328
#define XB_TOPGEN   3392
#define XCD_BAR_WORDS 3456
#define XB_SPIN_CAP (1u << 22)
__device__ __forceinline__ unsigned xb_ld(unsigned* p)              { return __hip_atomic_load(p, __ATOMIC_RELAXED, __HIP_MEMORY_SCOPE_AGENT); }
__device__ __forceinline__ unsigned xb_add(unsigned* p, unsigned v) { return __hip_atomic_fetch_add(p, v, __ATOMIC_RELAXED, __HIP_MEMORY_SCOPE_AGENT); }
__device__ __forceinline__ unsigned xb_xcc_id() { return (unsigned)__builtin_amdgcn_s_getreg((3 << 11) | 20) & 0xFu; }
#define XB_SPIN(cond, bar) do { unsigned _sp = 0; while (cond) { __builtin_amdgcn_s_sleep(1); \
    if ((++_sp & 255u) == 0u) { if (xb_ld(&(bar)[XB_TMO])) break; if (_sp > XB_SPIN_CAP) { atomicAdd(&(bar)[XB_TMO], 1u); break; } } } } while (0)
struct XcdBarrier { unsigned* bar; unsigned x; volatile LAS unsigned* st; };
__device__ __forceinline__ XcdBarrier xcd_barrier_post(unsigned* bar, volatile LAS unsigned* st) {
    XcdBarrier b; b.bar = bar; b.x = xb_xcc_id(); b.st = st;
    if (threadIdx.x == 0) (void)xb_add(&bar[XB_XCNT(b.x)], 1u);
    return b;
}
__device__ __forceinline__ void xcd_barrier_complete(unsigned* bar, unsigned x, unsigned& nloc, unsigned& nx) {
    const unsigned G = gridDim.x * gridDim.y * gridDim.z;
    unsigned sum, cnt, mine, sp = 0u;
    for (;;) {
        sum = 0u; cnt = 0u; mine = 0u;
#pragma unroll
        for (unsigned j = 0; j < 16; ++j) { const unsigned c = xb_ld(&bar[XB_XCNT(j)]); sum += c; cnt += (c > 0u) ? 1u : 0u; mine = (j == x) ? c : mine; }
        if (sum == G) break;
        __builtin_amdgcn_s_sleep(1);
        if ((++sp & 255u) == 0u) { if (xb_ld(&bar[XB_TMO])) break; if (sp > XB_SPIN_CAP) { atomicAdd(&bar[XB_TMO], 1u); break; } }
    }
    nloc = mine > 0u ? mine : 1u; nx = cnt > 0u ? cnt : 1u;
}
__device__ __forceinline__ void xcd_barrier(const XcdBarrier& b) {
    asm volatile("s_waitcnt vmcnt(0)" ::: "memory");
    __syncthreads();
    if (threadIdx.x == 0) {
        unsigned* bar = b.bar;
        __builtin_amdgcn_s_waitcnt(0);
        unsigned nloc = b.st[0], nx = b.st[1];
        if (nloc == 0u) { xcd_barrier_complete(bar, b.x, nloc, nx); b.st[0] = nloc; b.st[1] = nx; }
        const unsigned old = xb_add(&bar[XB_XSUB(b.x)], 1u);
        const unsigned gen = old / nloc;
        const unsigned target = (gen + 1u) * nx;
        if (old + 1u == (gen + 1u) * nloc) {
            __builtin_amdgcn_fence(__ATOMIC_RELEASE, "agent");
            asm volatile("s_waitcnt vmcnt(0)" ::: "memory");
            xb_add(&bar[XB_TOP], 1u);
        }
        XB_SPIN(xb_ld(&bar[XB_TOP]) < target, bar);
        __builtin_amdgcn_fence(__ATOMIC_ACQUIRE, "agent");
        asm volatile("s_waitcnt vmcnt(0)" ::: "memory");
    }
    __syncthreads();
}

__device__ __forceinline__ int next_item(unsigned* q, volatile LAS unsigned* slot) {
    if (threadIdx.x == 0) *slot = __hip_atomic_fetch_add(q, 1u, __ATOMIC_RELAXED, __HIP_MEMORY_SCOPE_AGENT);
    __syncthreads();
    const int it = (int)*slot;
    __syncthreads();
    return it;
}

extern __shared__ __attribute__((aligned(16))) unsigned char g_shm[];

enum { K_PREP = 0, K_NORM, K_GS, K_E2, K_E3, K_O2, K_O4, K_GR_UNUSED, K_F1 };
__device__ __forceinline__ void decode_phase(int ph, int& kind, int& l, int& var) {
    if (ph == 0) { kind = K_PREP; l = 0; var = 0; return; }
    if (ph == N_PHASES - 1) { kind = K_NORM; l = 0; var = 2; return; }
    int q = ph - 1;
    if (q < 8) l = 0; else if (q < 17) { l = 1; q -= 8; } else if (q < 25) { l = 2; q -= 17; } else { l = 3; q -= 25; }
    if ((l & 1) == 0) {
        switch (q) { case 0: kind = K_NORM; var = 0; break; case 1: kind = K_GS; var = 0; break; case 2: kind = K_E2; var = 0; break; case 3: kind = K_E3; var = 0; break;
                     case 4: kind = K_GS; var = 3; break; case 5: kind = K_NORM; var = 1; break; case 6: kind = K_F1; var = 0; break; default: kind = K_GS; var = 4; break; }
    } else {
        switch (q) { case 0: kind = K_NORM; var = 0; break; case 1: kind = K_GS; var = 1; break; case 2: kind = K_O2; var = 0; break; case 3: kind = K_GS; var = 2; break; case 4: kind = K_O4; var = 0; break;
                     case 5: kind = K_GS; var = 3; break; case 6: kind = K_NORM; var = 1; break; case 7: kind = K_F1; var = 0; break; default: kind = K_GS; var = 4; break; }
    }
}

__global__ void __launch_bounds__(512, 2) mega(Params p_arg) {
    cg::grid_group grid = cg::this_grid();
    const int ph_lo = get_params()->ph_lo, ph_hi = get_params()->ph_hi;
    volatile LAS unsigned* xb_st = (volatile LAS unsigned*)((LAS unsigned char*)g_shm + (LDS_BYTES - 16));
    XcdBarrier xb; xb.bar = (unsigned*)(get_params()->ws + WS_BAR); xb.x = 0; xb.st = xb_st;
    if (ph_hi - ph_lo > 1) { if (threadIdx.x == 0) { xb_st[0] = 0u; xb_st[1] = 0u; } __syncthreads(); xb = xcd_barrier_post(xb.bar, xb_st); }
    for (int ph = ph_lo; ph < ph_hi; ++ph) {
        PRef p = *get_params();
        unsigned char* shm = g_shm;
        LAS unsigned char* lds = (LAS unsigned char*)g_shm;
        const int wg = bidx(), G = gdim();
        unsigned char* ws = p.ws;
        int kind, l, var; decode_phase(ph, kind, l, var);
        const int j = l >> 1;
        const int nrep = (kind == REP_KIND && (REP_VAR < 0 || var == REP_VAR)) ? 1 + REP_N : 1;
        for (int rep = 0; rep < nrep; ++rep)
        switch (kind) {
        case K_PREP: phase_prep(p, shm); break;
        case K_NORM: phase_norm(p, l, var); break;
        case K_GS: {
            const int nsub = var == 2 ? 3 : 1;
            if (var == 0) phase_zgemm(p, j, shm);
            for (int gi = 0; gi < nsub; ++gi) {
                pg8::Gemm g; pg8::EpiStore E; int c = wg, GG = G, ns = 1, ksub = 0;
                if (var == 3) { g = {(const bf16_t*)(ws + WS_MIX), (const bf16_t*)(ws + ((l & 1) ? WS_WOUTO : WS_WOUTE)) + (size_t)j * 1024 * 1024, T, 1024, 512, 1024}; E = {(bf16_t*)(ws + WS_P), 1024, 1024, (size_t)T * 1024}; ns = 2; ksub = 512; }
                else if (var == 4) { g = {(const bf16_t*)(ws + WS_ACT), (const bf16_t*)(ws + WS_WFO) + (size_t)l * 1024 * 2816, T, 1024, 1408, 2816}; E = {(bf16_t*)(ws + WS_P), 1024, 1024, (size_t)T * 1024}; ns = 2; ksub = 1408; }
                else if (var == 0) { g = {(const bf16_t*)(ws + WS_H), (const bf16_t*)(ws + WS_WINE) + (size_t)j * 2560 * 1024, T, 2560, 1024, 1024}; E = {(bf16_t*)(ws + WS_PROJ), 2560, 2560, 0}; }
                else if (var == 1) { g = {(const bf16_t*)(ws + WS_H), (const bf16_t*)(ws + WS_WINO) + (size_t)j * 2048 * 1024, T, 2048, 1024, 1024}; E = {(bf16_t*)(ws + WS_PROJ), 2048, 1984, 0}; }
                else {
                    int off;
                    if (gi == 0) { g = {(const bf16_t*)(ws + WS_CQN), (const bf16_t*)(ws + WS_WQB) + (size_t)j * 768 * 256, T, 768, 256, 256}; E = {(bf16_t*)(ws + WS_QMLA), 768, 768, 0}; off = 0; }
                    else if (gi == 1) { g = {(const bf16_t*)(ws + WS_CKV) + (size_t)j * TK * 256, (const bf16_t*)(ws + WS_WKVK) + (size_t)j * 512 * 256, TK, 512, 256, 256}; E = {(bf16_t*)(ws + WS_KNOPE), 512, 512, 0}; off = 72; }
                    else { g = {(const bf16_t*)(ws + WS_WKVV) + (size_t)j * 512 * 256, (const bf16_t*)(ws + WS_CKV) + (size_t)j * TK * 256, 512, TK, 256, 256}; E = {(bf16_t*)(ws + WS_VTM), TK, TK, 0}; off = 128; }
                    if (G >= 184) { c = wg - off; GG = 256; }
                }
                pg8::Order S; S.init(g.M, g.N, GG, c, ns, ksub);
                pg8::gemm_phase(lds, g, S, E);
            }
            if (var == 4 && l < 3 && G == 256) { if (wg >= 192) conv_layer(p, l + 1, wg - 192, 64, (float*)shm, 2); }
        } break;
        case K_E2: {
            unsigned* q = (unsigned*)(ws + WS_BAR) + 16 + l * 4; volatile LAS unsigned* slot = (volatile LAS unsigned*)((LAS unsigned char*)g_shm + (LDS_BYTES - 32));
            for (;;) { const int it = next_item(q, slot); if (it >= 880) break; if (it < 112) gqa_prep(p, j, it, shm); else gla_pass_a(p, j, it - 112, shm); }
        } break;
        case K_E3: {
            unsigned* q = (unsigned*)(ws + WS_BAR) + 17 + l * 4; volatile LAS unsigned* slot = (volatile LAS unsigned*)((LAS unsigned char*)g_shm + (LDS_BYTES - 32));
            for (;;) { const int it = next_item(q, slot); if (it >= 768) break;
                if (it < 128 || (it >= 256 && it < 512)) gla_pass_b(p, j, it < 128 ? 256 + it : it - 256, shm); else gqa_attn_item(p, it < 256 ? it - 128 : it - 384, shm); }
        } break;
        case K_O2:
            for (int it = wg; it < 384; it += G) odd_prep(p, j, it, shm);
            break;
        case K_O4: {
            unsigned* q = (unsigned*)(ws + WS_BAR) + 18 + l * 4; volatile LAS unsigned* slot = (volatile LAS unsigned*)((LAS unsigned char*)g_shm + (LDS_BYTES - 32));
            for (;;) { const int it = next_item(q, slot); if (it >= 576) break;
                if (it < 192) hyena_conv(p, j, it < 64 ? 1 : 0, it < 64 ? 0 : (it - 64) >> 6, it < 64 ? it : (it - 64) & 63, shm);
                else mla_attn_item(p, j, it - 192, shm); }
        } break;
        default: {
            pg8::Gemm g{(const bf16_t*)(ws + WS_H), (const bf16_t*)(ws + WS_WFI) + (size_t)l * 5632 * 1024, T, 5632, 1024, 1024};
            pg8::Order S; S.init(T, 5632, G, wg); pg8::EpiSwiglu E{(bf16_t*)(ws + WS_ACT)};
            pg8::gemm_phase(lds, g, S, E);
            if (l < 3) {
                const int nlast = 528 - 2 * G;
                if (G == 256 && nlast > 0) { if (wg >= nlast) conv_layer(p, l + 1, wg - nlast, G - nlast, (float*)shm, 1); }
                else conv_layer(p, l + 1, wg, G, (float*)shm); }
        } break;
        }
        if (ph + 1 < ph_hi) { if (USE_CG_SYNC || ph_hi > 100000) grid.sync(); else xcd_barrier(xb); }
        for (int es = 0; es < EXTRA_SYNC; ++es) xcd_barrier(xb);
    }
}

extern "C" void kernel_launch(void* const* d_in, const int* in_sizes, int n_in, void* d_out, int out_size, void* d_ws, size_t ws_size, hipStream_t stream) {
    static int grid = 0;
    if (grid == 0) {
        if (n_in != NIN || ws_size < WS_END) { fprintf(stderr, "kernel_launch: unexpected n_in %d / ws_size %zu (need %zu)\n", n_in, ws_size, (size_t)WS_END); grid = -1; return; }
        int dev = 0, cus = 0, per_cu = 0;
        hipGetDevice(&dev); hipDeviceGetAttribute(&cus, hipDeviceAttributeMultiprocessorCount, dev);
        if (hipFuncSetAttribute((const void*)mega, hipFuncAttributeMaxDynamicSharedMemorySize, LDS_BYTES) != hipSuccess) { fprintf(stderr, "kernel_launch: hipFuncSetAttribute failed\n"); grid = -1; return; }
        if (hipOccupancyMaxActiveBlocksPerMultiprocessor(&per_cu, (const void*)mega, 512, LDS_BYTES) != hipSuccess || per_cu < 1) { fprintf(stderr, "kernel_launch: occupancy query says %d\n", per_cu); per_cu = 1; }
        (void)hipGetLastError();
        grid = cus;
        if (grid > 256) grid = 256;
    }
    if (grid < 0) return;
    Params p{};
    for (int i = 0; i < NIN; ++i) p.in[i] = (const float*)d_in[i];
    p.out = (float*)d_out; p.ws = (unsigned char*)d_ws;
#if MULTI_LAUNCH
    for (int ph = 0; ph < N_PHASES; ++ph) { p.ph_lo = ph; p.ph_hi = ph + 1; hipLaunchKernelGGL(mega, dim3(grid), dim3(512), LDS_BYTES, stream, p); }
#else
    p.ph_lo = 0; p.ph_hi = N_PHASES;
    if (hipMemsetAsync((unsigned char*)d_ws + WS_BAR, 0, 16384, stream) != hipSuccess) { fprintf(stderr, "kernel_launch: memset of barrier words failed\n"); return; }
    void* args[] = {&p};
    hipError_t e = hipLaunchCooperativeKernel((const void*)mega, dim3(grid), dim3(512), args, LDS_BYTES, stream);
    if (e != hipSuccess) fprintf(stderr, "cooperative launch failed: %s (grid %d)\n", hipGetErrorString(e), grid);
#endif
}
```

```cpp
#include <hip/hip_runtime.h>
#include <hip/hip_cooperative_groups.h>
#include <cstdio>
namespace cg = cooperative_groups;

#ifndef REP_KIND
#define REP_KIND -1
#endif
#ifndef REP_VAR
#define REP_VAR -1
#endif
#ifndef REP_N
#define REP_N 0
#endif
#ifndef REP_SUB
#define REP_SUB 0
#endif
#ifndef USE_CG_SYNC
#define USE_CG_SYNC 0
#endif
#ifndef EXTRA_SYNC
#define EXTRA_SYNC 0
#endif
#ifndef MULTI_LAUNCH
#define MULTI_LAUNCH 0
#endif

#define LAS __attribute__((address_space(3)))
typedef unsigned short bf16_t;
typedef short bf16x8 __attribute__((ext_vector_type(8)));
typedef float f32x4 __attribute__((ext_vector_type(4)));
typedef float f32x16 __attribute__((ext_vector_type(16)));
typedef unsigned u32x4 __attribute__((ext_vector_type(4)));
typedef unsigned u32x2 __attribute__((ext_vector_type(2)));

constexpr int T = 6144, TK = 7168;
constexpr int NIN = 39;
constexpr float EPS = 1e-6f;
constexpr int N_PHASES = 36;
constexpr int PLO = 2112;

constexpr size_t O_YP = 0, O_YS = 4194304, O_SF = 6291456, O_SB = 7340032, O_CK = 8388608, O_CV = 10485760, O_CKV = 12582912, O_KPE = 13631488;

constexpr size_t al256(size_t x) { return (x + 255) & ~(size_t)255; }
constexpr size_t WS_X = 0;
constexpr size_t WS_H = WS_X + al256((size_t)T * 1024 * 4);
constexpr size_t WS_MOD = WS_H + al256((size_t)T * 1024 * 2);
constexpr size_t WS_PROJ = WS_MOD + al256((size_t)4 * 3 * 6144 * 4);
constexpr size_t WS_ZG = WS_PROJ + al256((size_t)T * 2560 * 2);
constexpr size_t WS_WZ = WS_ZG + al256((size_t)T * 32 * 4);
constexpr size_t WS_MIX = WS_WZ + al256((size_t)2 * 32 * 1024 * 2);
constexpr size_t WS_ACT = WS_MIX + al256((size_t)T * 1024 * 2);
constexpr size_t WS_WINE = WS_ACT + al256((size_t)T * 2816 * 2);
constexpr size_t WS_WOUTE = WS_WINE + al256((size_t)2 * 2560 * 1024 * 2);
constexpr size_t WS_WINO = WS_WOUTE + al256((size_t)2 * 1024 * 1024 * 2);
constexpr size_t WS_WOUTO = WS_WINO + al256((size_t)2 * 2048 * 1024 * 2);
constexpr size_t WS_WQB = WS_WOUTO + al256((size_t)2 * 1024 * 1024 * 2);
constexpr size_t WS_WKVK = WS_WQB + al256((size_t)2 * 768 * 256 * 2);
constexpr size_t WS_WKVV = WS_WKVK + al256((size_t)2 * 512 * 256 * 2);
constexpr size_t WS_WFI = WS_WKVV + al256((size_t)2 * 512 * 256 * 2);
constexpr size_t WS_WFO = WS_WFI + al256((size_t)4 * 5632 * 1024 * 2);
constexpr size_t WS_DS = WS_WFO + al256((size_t)4 * 1024 * 2816 * 2);
constexpr size_t WS_DEC = WS_DS + al256((size_t)768 * 64 * 128 * 4);
constexpr size_t WS_QNG = WS_DEC + al256((size_t)768 * 64 * 4);
constexpr size_t WS_KNG = WS_QNG + al256((size_t)T * 512 * 2);
constexpr size_t WS_VTG = WS_KNG + al256((size_t)TK * 256 * 2);
constexpr size_t WS_GR = WS_VTG + al256((size_t)256 * TK * 2);
constexpr size_t WS_X0 = WS_GR + al256((size_t)2 * 512 * 2560 * 2);
constexpr size_t WS_GV = WS_X0 + al256((size_t)T * 512 * 2);
constexpr size_t WS_GVT = WS_GV + al256((size_t)T * 512 * 2);
constexpr size_t WS_CQN = WS_GVT + al256((size_t)512 * T * 2);
constexpr size_t WS_CKV = WS_CQN + al256((size_t)T * 256 * 2);
constexpr size_t WS_KPE = WS_CKV + al256((size_t)2 * TK * 256 * 2);
constexpr size_t WS_QMLA = WS_KPE + al256((size_t)2 * TK * 64 * 2);
constexpr size_t WS_KNOPE = WS_QMLA + al256((size_t)T * 768 * 2);
constexpr size_t WS_VTM = WS_KNOPE + al256((size_t)TK * 512 * 2);
constexpr size_t WS_BAR = WS_VTM + al256((size_t)512 * TK * 2);
constexpr size_t WS_P = WS_BAR + 16384;
constexpr size_t WS_END = WS_P + al256((size_t)2 * T * 1024 * 2);

constexpr int LDS_BYTES = 139264;

struct Params {
    const float* in[NIN];
    float* out;
    unsigned char* ws;
    int ph_lo, ph_hi;
};

typedef const __attribute__((address_space(4))) Params& PRef;
typedef const __attribute__((address_space(4))) Params* PPtr;
__device__ __forceinline__ PPtr get_params() { PPtr q = (PPtr)__builtin_amdgcn_kernarg_segment_ptr(); asm volatile("" : "+s"(q)); return q; }

__device__ __forceinline__ int tidx() { int t = (int)__builtin_amdgcn_workitem_id_x(); asm volatile("" : "+v"(t)); return t; }
__device__ __forceinline__ int bidx() { int t = (int)__builtin_amdgcn_workgroup_id_x(); asm volatile("" : "+s"(t)); return t; }
__device__ __forceinline__ int gdim() { int t = (int)__ockl_get_num_groups(0); asm volatile("" : "+s"(t)); return t; }
__device__ __forceinline__ bf16_t f2bf(float f) { unsigned u = __float_as_uint(f); u += 0x7FFFu + ((u >> 16) & 1u); return (bf16_t)(u >> 16); }
__device__ __forceinline__ float bf2f(bf16_t b) { return __uint_as_float(((unsigned)b) << 16); }
typedef __bf16 bf16v2_t __attribute__((ext_vector_type(2)));
typedef float f32v2_t __attribute__((ext_vector_type(2)));
__device__ __forceinline__ unsigned pk2(float lo, float hi) { f32v2_t v; v[0] = lo; v[1] = hi; return __builtin_bit_cast(unsigned, __builtin_convertvector(v, bf16v2_t)); }
__device__ __forceinline__ float wave_sum(float v) {
#pragma unroll
    for (int o = 32; o > 0; o >>= 1) v += __shfl_xor(v, o, 64);
    return v;
}
__device__ __forceinline__ float silu_f(float g) { return g * __builtin_amdgcn_rcpf(1.0f + __expf(-g)); }
__device__ __forceinline__ int cvec_of(int r) { return r < 4096 ? 0 : 1 + ((r - 4096) >> 10); }
__device__ __forceinline__ f32x16 zero16() { f32x16 z;
#pragma unroll
    for (int i = 0; i < 16; ++i) z[i] = 0.f; return z; }
__device__ __forceinline__ f32x16 mfma32(bf16x8 a, bf16x8 b, f32x16 c) { return __builtin_amdgcn_mfma_f32_32x32x16_bf16(a, b, c, 0, 0, 0); }
__device__ __forceinline__ f32x16 mma_rows(const bf16_t* A, int lda, const bf16_t* B, int ldb, int K, f32x16 acc) {
    const int lane = tidx() & 63, r = lane & 31, h = lane >> 5;
    for (int k0 = 0; k0 < K; k0 += 16) {
        bf16x8 a = *(const bf16x8*)(A + r * lda + k0 + 8 * h);
        bf16x8 b = *(const bf16x8*)(B + r * ldb + k0 + 8 * h);
        acc = mfma32(a, b, acc);
    }
    return acc;
}

namespace pg8 {
constexpr int BM = 256, BK = 64, HALF = 128, HTB = HALF * BK * 2, STAGE_BYTES = 8 * HTB, NXCD = 8, WGM = 8;
__device__ __forceinline__ int lds_byte(int r, int c) { const int st = (r >> 4) * 2 + (c >> 5), rr = r & 15, cc = c & 31, ob = rr * 64 + cc * 2; return st * 1024 + (ob ^ (((ob >> 9) & 1) << 5)); }
__device__ __forceinline__ void stage_rc(int b, int& R, int& C) { const int st = b / 1024, sb = b % 1024, swz = sb ^ (((sb >> 9) & 1) << 5); R = (st >> 1) * 16 + swz / 64; C = (st & 1) * 32 + (swz % 64) / 2; }
__device__ __forceinline__ int perm32(int rho) { const int n = rho >> 4, i = rho & 15; return 8 * (i >> 2) + 4 * n + (i & 3); }
struct Unit { int pm, pn, sp, ko; };
struct Gemm { const bf16_t* A; const bf16_t* Bt; int M, N, K, ld; };
struct Order {
    int nM, nN, nwg, G, c, ns, ksub;
    __device__ void init(int M, int N, int G_, int c_, int ns_ = 1, int ksub_ = 0) { nM = M / BM; nN = N / BM; nwg = nM * nN; G = G_; c = c_; ns = ns_; ksub = ksub_; }
    __device__ bool next(int i, Unit& u) const {
        if (c < 0) return false;
        const long L = (long)i * G + c; if (L >= (long)nwg * ns) return false;
        const int sp = (int)(L / nwg);
        int wgid = (int)(L % nwg); { const int q = nwg / NXCD, r = nwg % NXCD, xcd = wgid % NXCD, off = wgid / NXCD; wgid = (xcd < r ? xcd * (q + 1) : r * (q + 1) + (xcd - r) * q) + off; }
        const int nig = WGM * nN, gid = wgid / nig, fm = gid * WGM, gsz = (nM - fm) < WGM ? (nM - fm) : WGM;
        u.pm = fm + ((wgid % nig) % gsz); u.pn = (wgid % nig) / gsz; u.sp = sp; u.ko = sp * ksub; return true;
    }
};

template <class Epi>
__device__ __forceinline__ void gemm_phase(LAS unsigned char* lds, const Gemm g, const Order& S, const Epi& E) {
    const int tid = tidx(), wid = __builtin_amdgcn_readfirstlane(tid >> 6), lane = tid & 63, wr = wid >> 2, wc = wid & 3, fr = lane & 15, fq = lane >> 4;
    const int K = g.ld, nt = g.K / BK;
    unsigned voffA[2], voffB[2];
#pragma unroll
    for (int i = 0; i < 2; ++i) { int R, C; stage_rc(tid * 16 + i * 8192, R, C); const int Rb = Epi::PERM ? ((R & ~31) + perm32(R & 31)) : R;
        voffA[i] = (unsigned)(R * K + C) * 2u; voffB[i] = (unsigned)(Rb * K + C) * 2u; }
    const size_t kstep = (size_t)(BK * 2);
    const size_t hstep = (size_t)HALF * K * 2;
    const size_t tstep = 2 * hstep;
    const unsigned ldsw = (unsigned)wid * 1024u;
    const int aoff = lds_byte(wr * 64 + fr, fq * 8), boff = lds_byte(wc * 32 + fr, fq * 8);
#define PG8_SA(b, h) (((b) * 2 + (h)) * HTB)
#define PG8_SB(b, h) ((4 + (b) * 2 + (h)) * HTB)
#define PG8_STAGE(bufoff, gbase, voff) do { _Pragma("unroll") for (int _i = 0; _i < 2; ++_i) \
        __builtin_amdgcn_global_load_lds((const unsigned*)((const char*)(gbase) + (voff)[_i]), (LAS unsigned*)(lds + (bufoff) + ldsw + _i * 8192), 16, 0, 0); } while (0)
#define PG8_LDA(dst, b, h) do { _Pragma("unroll") for (int m = 0; m < 4; ++m) _Pragma("unroll") for (int k = 0; k < 2; ++k) dst[m][k] = *(const LAS bf16x8*)(lds + PG8_SA(b, h) + aoff + m * 2048 + k * 1024); } while (0)
#define PG8_LDB(dst, b, h) do { _Pragma("unroll") for (int n = 0; n < 2; ++n) _Pragma("unroll") for (int k = 0; k < 2; ++k) dst[n][k] = *(const LAS bf16x8*)(lds + PG8_SB(b, h) + boff + n * 2048 + k * 1024); } while (0)
#define PG8_MMA(ai, bj, At, Bt) do { __builtin_amdgcn_s_setprio(1); _Pragma("unroll") for (int m = 0; m < 4; ++m) _Pragma("unroll") for (int n = 0; n < 2; ++n) _Pragma("unroll") for (int k = 0; k < 2; ++k) \
        acc[ai][bj][m][n] = __builtin_amdgcn_mfma_f32_16x16x32_bf16(Bt[n][k], At[m][k], acc[ai][bj][m][n], 0, 0, 0); __builtin_amdgcn_s_setprio(0); } while (0)
#define PG8_WAIT_V(n) asm volatile("s_waitcnt vmcnt(" #n ")" ::: "memory")
#define PG8_WAIT_L(n) asm volatile("s_waitcnt lgkmcnt(" #n ")" ::: "memory")
#define PG8_BAR __builtin_amdgcn_s_barrier()
#define PG8_SCHED __builtin_amdgcn_sched_barrier(0)
    Unit cur, nxt; int ui = 0;
    if (!S.next(0, cur)) return;
    f32x4 acc[2][2][4][2];
#pragma unroll
    for (int a = 0; a < 2; ++a)
#pragma unroll
        for (int b = 0; b < 2; ++b)
#pragma unroll
            for (int m = 0; m < 4; ++m)
#pragma unroll
                for (int n = 0; n < 2; ++n) acc[a][b][m][n] = (f32x4){0.f, 0.f, 0.f, 0.f};
    bf16x8 At[4][2], B0[2][2], B1[2][2];
    const char* cA = (const char*)g.A + (size_t)cur.pm * tstep + (size_t)cur.ko * 2; const char* cB = (const char*)g.Bt + (size_t)cur.pn * tstep + (size_t)cur.ko * 2;
    PG8_STAGE(PG8_SB(0, 0), cB, voffB); PG8_STAGE(PG8_SA(0, 0), cA, voffA); PG8_STAGE(PG8_SB(0, 1), cB + hstep, voffB); PG8_STAGE(PG8_SA(0, 1), cA + hstep, voffA);
    if (wr == 1) PG8_BAR;
    PG8_WAIT_V(4); PG8_BAR;
    PG8_STAGE(PG8_SB(1, 0), cB + kstep, voffB); PG8_STAGE(PG8_SA(1, 0), cA + kstep, voffA); PG8_STAGE(PG8_SB(1, 1), cB + hstep + kstep, voffB);
    PG8_WAIT_V(6); PG8_BAR;
    for (;;) {
        const bool has_next = S.next(ui + 1, nxt);
        const char* nA = has_next ? (const char*)g.A + (size_t)nxt.pm * tstep + (size_t)nxt.ko * 2 : cA; const char* nB = has_next ? (const char*)g.Bt + (size_t)nxt.pn * tstep + (size_t)nxt.ko * 2 : cB;
        for (int t = 0; t < nt; t += 2) {
            const bool last = (t == nt - 2);
            const char* a1 = cA + (size_t)(t + 1) * kstep;
            const char* a2 = last ? nA : cA + (size_t)(t + 2) * kstep; const char* b2 = last ? nB : cB + (size_t)(t + 2) * kstep;
            const char* a3 = a2 + kstep; const char* b3 = b2 + kstep;
            PG8_LDB(B0, 0, 0); PG8_SCHED; PG8_LDA(At, 0, 0); PG8_STAGE(PG8_SA(1, 1), a1 + hstep, voffA);
            PG8_WAIT_L(8); PG8_BAR; PG8_WAIT_L(0); PG8_MMA(0, 0, At, B0); PG8_BAR; PG8_SCHED;
            PG8_LDB(B1, 0, 1); PG8_STAGE(PG8_SB(0, 0), b2, voffB);
            PG8_BAR; PG8_WAIT_L(0); PG8_MMA(0, 1, At, B1); PG8_BAR;
            PG8_LDA(At, 0, 1); PG8_STAGE(PG8_SA(0, 0), a2, voffA);
            PG8_BAR; PG8_WAIT_L(0); PG8_MMA(1, 0, At, B0); PG8_BAR; PG8_SCHED;
            PG8_STAGE(PG8_SB(0, 1), b2 + hstep, voffB);
            PG8_WAIT_V(6); PG8_BAR; PG8_MMA(1, 1, At, B1); PG8_BAR;
            PG8_LDB(B0, 1, 0); PG8_SCHED; PG8_LDA(At, 1, 0); PG8_STAGE(PG8_SA(0, 1), a2 + hstep, voffA);
            PG8_WAIT_L(8); PG8_BAR; PG8_WAIT_L(0); PG8_MMA(0, 0, At, B0); PG8_BAR; PG8_SCHED;
            PG8_LDB(B1, 1, 1); PG8_STAGE(PG8_SB(1, 0), b3, voffB);
            PG8_BAR; PG8_WAIT_L(0); PG8_MMA(0, 1, At, B1); PG8_BAR;
            PG8_LDA(At, 1, 1); PG8_STAGE(PG8_SA(1, 0), a3, voffA);
            PG8_BAR; PG8_WAIT_L(0); PG8_MMA(1, 0, At, B0); PG8_BAR; PG8_SCHED;
            PG8_STAGE(PG8_SB(1, 1), b3 + hstep, voffB);
            PG8_WAIT_V(6); PG8_BAR; PG8_MMA(1, 1, At, B1); PG8_BAR;
        }
        E(acc, cur, wr, wc, fr, fq);
        if (!has_next) break;
#pragma unroll
        for (int a = 0; a < 2; ++a)
#pragma unroll
            for (int b = 0; b < 2; ++b)
#pragma unroll
                for (int m = 0; m < 4; ++m)
#pragma unroll
                    for (int n = 0; n < 2; ++n) acc[a][b][m][n] = (f32x4){0.f, 0.f, 0.f, 0.f};
        cur = nxt; cA = nA; cB = nB; ++ui;
    }
    PG8_WAIT_V(0);
    if (wr == 0) PG8_BAR;
    PG8_BAR;
#undef PG8_SA
#undef PG8_SB
#undef PG8_STAGE
#undef PG8_LDA
#undef PG8_LDB
#undef PG8_MMA
#undef PG8_WAIT_V
#undef PG8_WAIT_L
#undef PG8_BAR
#undef PG8_SCHED
}
struct EpiStore {
    static constexpr bool PERM = true;
    bf16_t* O; int ldc; int ncols; size_t split_stride;
    __device__ __forceinline__ void operator()(const f32x4 (&acc)[2][2][4][2], const Unit& u, int wr, int wc, int fr, int fq) const {
        const int row0 = u.pm * BM + wr * 64 + fr, col0 = u.pn * BM + wc * 32 + 8 * fq;
#pragma unroll
        for (int ai = 0; ai < 2; ++ai)
#pragma unroll
            for (int m = 0; m < 4; ++m) { bf16_t* rowp = O + (size_t)u.sp * split_stride + (size_t)(row0 + ai * HALF + m * 16) * ldc;
#pragma unroll
                for (int bj = 0; bj < 2; ++bj) { const int col = col0 + bj * HALF; if (col < ncols) {
                    const f32x4 v0 = acc[ai][bj][m][0], v1 = acc[ai][bj][m][1];
                    u32x4 o; o[0] = pk2(v0[0], v0[1]); o[1] = pk2(v0[2], v0[3]); o[2] = pk2(v1[0], v1[1]); o[3] = pk2(v1[2], v1[3]);
                    *(u32x4*)(rowp + col) = o; } } }
    }
};
struct EpiSwiglu {
    static constexpr bool PERM = true;
    bf16_t* O;
    __device__ __forceinline__ void operator()(const f32x4 (&acc)[2][2][4][2], const Unit& u, int wr, int wc, int fr, int fq) const {
        const int row0 = u.pm * BM + wr * 64 + fr, col0 = u.pn * 128 + wc * 32 + 8 * fq;
#pragma unroll
        for (int ai = 0; ai < 2; ++ai)
#pragma unroll
            for (int m = 0; m < 4; ++m) { bf16_t* rowp = O + (size_t)(row0 + ai * HALF + m * 16) * 2816 + col0;
                float r[8];
#pragma unroll
                for (int n = 0; n < 2; ++n)
#pragma unroll
                    for (int q = 0; q < 4; ++q) r[n * 4 + q] = silu_f(acc[ai][0][m][n][q]) * acc[ai][1][m][n][q];
                u32x4 o; o[0] = pk2(r[0], r[1]); o[1] = pk2(r[2], r[3]); o[2] = pk2(r[4], r[5]); o[3] = pk2(r[6], r[7]);
                *(u32x4*)rowp = o; }
    }
};
}

struct Job { const float* src; int ld, Ks, mode; bf16_t* dst; int Nd, Kd; };
__device__ __forceinline__ int job_srccol(int mode, int n0) {
    switch (mode) {
        case 0: return n0;
        case 1: return n0 < 1536 ? n0 : n0 + 32;
        case 2: return 1536;
        case 3: return n0 < 1984 ? n0 : -1;
        case 4: return (n0 >> 7) * 256 + (n0 & 127);
        case 5: return (n0 >> 7) * 256 + 128 + (n0 & 127);
        default: { const int pn = n0 >> 8, x0 = n0 & 255; return x0 < 128 ? pn * 128 + x0 : 2816 + pn * 128 + x0 - 128; }
    }
}
__device__ __forceinline__ Job get_job(PRef p, int idx) {
    Job j; unsigned char* ws = p.ws;
    if (idx < 2)       { const int i = idx;      j = {p.in[12] + (size_t)i * 1024 * 2592, 2592, 1024, 1, (bf16_t*)(ws + WS_WINE) + (size_t)i * 2560 * 1024, 2560, 1024}; }
    else if (idx < 4)  { const int i = idx - 2;  j = {p.in[12] + (size_t)i * 1024 * 2592, 2592, 1024, 2, (bf16_t*)(ws + WS_WZ) + (size_t)i * 32 * 1024, 32, 1024}; }
    else if (idx < 6)  { const int i = idx - 4;  j = {p.in[20] + (size_t)i * 1024 * 1024, 1024, 1024, 0, (bf16_t*)(ws + WS_WOUTE) + (size_t)i * 1024 * 1024, 1024, 1024}; }
    else if (idx < 8)  { const int i = idx - 6;  j = {p.in[21] + (size_t)i * 1024 * 1984, 1984, 1024, 3, (bf16_t*)(ws + WS_WINO) + (size_t)i * 2048 * 1024, 2048, 1024}; }
    else if (idx < 10) { const int i = idx - 8;  j = {p.in[35] + (size_t)i * 1024 * 1024, 1024, 1024, 0, (bf16_t*)(ws + WS_WOUTO) + (size_t)i * 1024 * 1024, 1024, 1024}; }
    else if (idx < 12) { const int i = idx - 10; j = {p.in[32] + (size_t)i * 256 * 768, 768, 256, 0, (bf16_t*)(ws + WS_WQB) + (size_t)i * 768 * 256, 768, 256}; }
    else if (idx < 14) { const int i = idx - 12; j = {p.in[34] + (size_t)i * 128 * 1024, 1024, 128, 4, (bf16_t*)(ws + WS_WKVK) + (size_t)i * 512 * 256, 512, 256}; }
    else if (idx < 16) { const int i = idx - 14; j = {p.in[34] + (size_t)i * 128 * 1024, 1024, 128, 5, (bf16_t*)(ws + WS_WKVV) + (size_t)i * 512 * 256, 512, 256}; }
    else if (idx < 20) { const int i = idx - 16; j = {p.in[36] + (size_t)i * 1024 * 5632, 5632, 1024, 6, (bf16_t*)(ws + WS_WFI) + (size_t)i * 5632 * 1024, 5632, 1024}; }
    else               { const int i = idx - 20; j = {p.in[37] + (size_t)i * 2816 * 1024, 1024, 2816, 0, (bf16_t*)(ws + WS_WFO) + (size_t)i * 1024 * 2816, 1024, 2816}; }
    return j;
}
constexpr int N_JOBS = 24;

__device__ __forceinline__ void conv_tile(const Job& jb, int tile, float* tl) {
    const int nkt = jb.Kd >> 8; const int nti = tile / nkt, kt = tile % nkt; const int n0 = nti * 64, k0 = kt * 256;
    const int sc = job_srccol(jb.mode, n0);
    const int t = tidx();
    if (sc >= 0) {
        f32x4 v[8];
#pragma unroll
        for (int q = 0; q < 8; ++q) { const int idx = t + 512 * q, k = idx >> 4, c4 = idx & 15;
            v[q] = (k0 + k < jb.Ks) ? *(const f32x4*)(jb.src + (size_t)(k0 + k) * jb.ld + sc + c4 * 4) : (f32x4){0.f, 0.f, 0.f, 0.f}; }
#pragma unroll
        for (int q = 0; q < 8; ++q) { const int idx = t + 512 * q, k = idx >> 4, c4 = idx & 15; float* d = tl + k * 65 + c4 * 4; d[0] = v[q][0]; d[1] = v[q][1]; d[2] = v[q][2]; d[3] = v[q][3]; } }
    __syncthreads();
    { const int kq = t & 7, n = t >> 3;
      if (n0 + n < jb.Nd) {
#pragma unroll
          for (int m = 0; m < 4; ++m) { const int kc = kq + 8 * m; float v[8];
#pragma unroll
              for (int i = 0; i < 8; ++i) v[i] = sc < 0 ? 0.f : tl[(kc * 8 + i) * 65 + n];
              u32x4 o; o[0] = pk2(v[0], v[1]); o[1] = pk2(v[2], v[3]); o[2] = pk2(v[4], v[5]); o[3] = pk2(v[6], v[7]);
              *(u32x4*)(jb.dst + (size_t)(n0 + n) * jb.Kd + k0 + kc * 8) = o; } } }
    __syncthreads();
}

__device__ __forceinline__ int layer_job(int l, int k) {
    const int j = l >> 1;
    if ((l & 1) == 0) { switch (k) { case 0: return j; case 1: return 2 + j; case 2: return 4 + j; case 3: return 16 + l; case 4: return 20 + l; default: return -1; } }
    switch (k) { case 0: return 6 + j; case 1: return 8 + j; case 2: return 10 + j; case 3: return 12 + j; case 4: return 14 + j; case 5: return 16 + l; case 6: return 20 + l; default: return -1; }
}
__device__ __forceinline__ void conv_layer(PRef p, int l, int wi, int nw, float* tl, int which = 0  ) {
    int tbase = 0;
    for (int k = 0; k < 7; ++k) { const int ji = layer_job(l, k); if (ji < 0) break;
        const bool is_fo = ji >= 20; if ((which == 1 && is_fo) || (which == 2 && !is_fo)) continue;
        const Job jb = get_job(p, ji); const int ntile = ((jb.Nd + 63) >> 6) * (jb.Kd >> 8);
        const int first = (wi - (tbase % nw) + nw) % nw;
        for (int tile = first; tile < ntile; tile += nw) conv_tile(jb, tile, tl);
        tbase += ntile; }
}

__device__ __forceinline__ void phase_prep(PRef p, unsigned char* shm) {
    const int t = tidx(), wg = bidx(), nwg = gdim();
    unsigned char* ws = p.ws;
    { float* X = (float*)(ws + WS_X); const f32x4* xp = (const f32x4*)p.in[0]; const f32x4* xs = (const f32x4*)p.in[1]; f32x4* X4 = (f32x4*)X;
      const size_t n4 = (size_t)T * 256, np4 = (size_t)4096 * 256;
      for (size_t i = (size_t)wg * 512 + t; i < n4; i += (size_t)nwg * 512) X4[i] = i < np4 ? xp[i] : xs[i - np4];
      bf16_t* CKV = (bf16_t*)(ws + WS_CKV); bf16_t* KPE = (bf16_t*)(ws + WS_KPE);
      for (size_t i = (size_t)wg * 512 + t; i < (size_t)2 * TK * 256; i += (size_t)nwg * 512) {
          const int j = (int)(i / ((size_t)TK * 256)); const int rem = (int)(i % ((size_t)TK * 256)); const int r = rem >> 8, c = rem & 255;
          if (c >= 128) CKV[i] = 0;
          else if (r >= T) { const int b = (r - T) >> 9, pp = (r - T) & 511; CKV[i] = f2bf(p.in[6][((size_t)(b * 2 + j) * 512 + pp) * 128 + c]); } }
      for (size_t i = (size_t)wg * 512 + t; i < (size_t)2 * 1024 * 64; i += (size_t)nwg * 512) {
          const int j = (int)(i >> 16); const int rem = (int)(i & 65535); const int rr = rem >> 6, c = rem & 63; const int b = rr >> 9, pp = rr & 511;
          KPE[((size_t)j * TK + T + rr) * 64 + c] = f2bf(p.in[7][((size_t)(b * 2 + j) * 512 + pp) * 64 + c]); } }
    float* sc = (float*)(shm + 81920);
    float* red = sc + 3072;
    {
      for (int i = t; i < 3072; i += 512) { const int ci = i >> 10, k = i & 1023; const float v = ci == 0 ? p.in[9][k] : p.in[8][(ci - 1) * 1024 + k]; sc[i] = silu_f(v); }
      __syncthreads();
      }
    auto adaln_task = [&](int task) {
          float* MOD = (float*)(ws + WS_MOD);
          const int l = task / 96, cb = task % 96; const int col = t & 63, kg = t >> 6;
          const float* w = p.in[10] + (size_t)l * 1024 * 6144 + cb * 64 + col;
          float a0 = 0.f, a1 = 0.f, a2 = 0.f;
#pragma unroll 8
          for (int k = kg * 128; k < kg * 128 + 128; ++k) { const float wv = w[(size_t)k * 6144]; a0 += sc[k] * wv; a1 += sc[1024 + k] * wv; a2 += sc[2048 + k] * wv; }
          red[(kg * 3 + 0) * 64 + col] = a0; red[(kg * 3 + 1) * 64 + col] = a1; red[(kg * 3 + 2) * 64 + col] = a2;
          __syncthreads();
          if (t < 192) { const int ci = t >> 6, c2 = t & 63; float s = p.in[11][(size_t)l * 6144 + cb * 64 + c2];
#pragma unroll
              for (int g = 0; g < 8; ++g) s += red[(g * 3 + ci) * 64 + c2];
              MOD[((size_t)l * 3 + ci) * 6144 + cb * 64 + c2] = s; }
          __syncthreads();
      };
    float* zf = (float*)shm;
    float* h1 = zf + 320;
    float* h2 = h1 + 512;
    bf16_t* GR = (bf16_t*)(ws + WS_GR);
    auto filter_task = [&](int task) {
          const int j = task / 160, tb = task % 160; const int type = tb < 32 ? 0 : 1; const int L = type ? 1024 : 256; const int pos0 = (type ? tb - 32 : tb) * 8;
          if (t < 8 * 33) { const int pi = t / 33, e = t % 33; const int idx = pos0 + pi; float v;
              if (e == 0) v = (float)idx / (float)(L - 1);
              else { const int b = (e - 1) & 15; const float f = 1e-4f + (float)b * ((15.0f - 1e-4f) / 15.0f); const float w = 6.283185307179586f * (float)idx / (float)L; v = e <= 16 ? __cosf(f * w) : -__sinf(f * w); }
              zf[pi * 40 + e] = v; }
          __syncthreads();
          { const int pi = t >> 6, u = t & 63; float s = p.in[26][j * 64 + u]; const float* w1 = p.in[25] + (size_t)j * 33 * 64 + u;
            for (int e = 0; e < 33; ++e) s += zf[pi * 40 + e] * w1[e * 64];
            h1[pi * 64 + u] = __sinf(p.in[27][j * 64 + u] * s); }
          __syncthreads();
          { const int pi = t >> 6, u = t & 63; float s = p.in[29][j * 64 + u]; const float* w2 = p.in[28] + (size_t)j * 64 * 64 + u;
            for (int e = 0; e < 64; ++e) s += h1[pi * 64 + e] * w2[e * 64];
            h2[pi * 64 + u] = __sinf(p.in[27][j * 64 + u] * s); }
          __syncthreads();
          { const float* w3 = p.in[30] + (size_t)j * 64 * 1024;
            bf16_t* gr = GR + (size_t)j * 512 * 2560 + (type ? (size_t)512 * 512 : 0);
            for (int cc = 0; cc < 2; ++cc) { const int col = t + cc * 512; float a[8];
#pragma unroll
                for (int q = 0; q < 8; ++q) a[q] = 0.f;
                for (int e = 0; e < 64; ++e) { const float wv = w3[e * 1024 + col];
#pragma unroll
                    for (int q = 0; q < 8; ++q) a[q] += h2[q * 64 + e] * wv; }
                const int ch = col & 511; const float delta = fabsf(-3.0701134573253945f + (float)ch * ((-15.350567286626973f + 3.0701134573253945f) / 511.0f));
                bf16_t* grc = gr + (size_t)ch * (2 * L);
#pragma unroll
                for (int q = 0; q < 8; ++q) { const int idx = pos0 + q; const float tp = (float)idx / (float)(L - 1); const float v = a[q] * __expf(-tp * delta);
                    if (col < 512) grc[L - 1 - idx] = f2bf(v);
                    else if (idx >= 1) grc[L - 1 + idx] = f2bf(v);
                    else grc[2 * L - 1] = 0; } } }
          __syncthreads();
      };
    { int jstart[8]; int total = 0;
#pragma unroll
      for (int k = 0; k < 7; ++k) { const int ji = layer_job(0, k); jstart[k] = total; if (ji >= 0) { const Job jb = get_job(p, ji); total += ((jb.Nd + 63) >> 6) * (jb.Kd >> 8); } }
      unsigned* q = (unsigned*)(ws + WS_BAR) + 15; volatile unsigned* slot = (volatile unsigned*)(shm + (LDS_BYTES - 32));
      for (;;) {
          if (threadIdx.x == 0) *slot = __hip_atomic_fetch_add(q, 1u, __ATOMIC_RELAXED, __HIP_MEMORY_SCOPE_AGENT);
          __syncthreads();
          const int it = (int)*slot;
          __syncthreads();
          if (it >= 704 + total) break;
          if (it < 320) filter_task(it);
          else if (it < 704) adaln_task(it - 320);
          else { const int idx = it - 704; int k = 0, base = 0;
#pragma unroll
              for (int z = 1; z < 7; ++z) if (idx >= jstart[z]) { k = z; base = jstart[z]; }
              const Job jb = get_job(p, layer_job(0, k)); conv_tile(jb, idx - base, (float*)shm); }
      } }
}

__device__ __forceinline__ void phase_norm(PRef p, int l, int which  ) {
    const int lane = tidx() & 63, wv = tidx() >> 6;
    float* X = (float*)(p.ws + WS_X); bf16_t* H = (bf16_t*)(p.ws + WS_H); const float* MOD = (const float*)(p.ws + WS_MOD); const bf16_t* P = (const bf16_t*)(p.ws + WS_P);
    const bool add = !(which == 0 && l == 0);
    const int gl = which == 1 ? l : (which == 2 ? 3 : l - 1); const int goff = which == 1 ? 2048 : 5120;
    const int stride = gdim() * 8;
    for (int rowb = bidx() * 8 + wv; rowb < T; rowb += 2 * stride) {
        f32x4 v[2][4]; float rstd[2];
#pragma unroll
        for (int u = 0; u < 2; ++u) { const int row = rowb + u * stride; if (row < T) {
            if (!add) { const f32x4* xi = (const f32x4*)(row < 4096 ? p.in[0] + (size_t)row * 1024 : p.in[1] + (size_t)(row - 4096) * 1024);
#pragma unroll
                for (int i = 0; i < 4; ++i) v[u][i] = xi[lane + 64 * i]; }
            else { const f32x4* xr = (const f32x4*)(X + (size_t)row * 1024);
#pragma unroll
                for (int i = 0; i < 4; ++i) v[u][i] = xr[lane + 64 * i]; } } }
        if (add) {
            f32x4 g[2][4]; u32x2 pa[2][4], pb[2][4];
#pragma unroll
            for (int u = 0; u < 2; ++u) { const int row = rowb + u * stride; if (row < T) { const float* gp = MOD + ((size_t)gl * 3 + cvec_of(row)) * 6144 + goff;
#pragma unroll
                for (int i = 0; i < 4; ++i) { g[u][i] = ((const f32x4*)gp)[lane + 64 * i];
                    pa[u][i] = *(const u32x2*)(P + (size_t)row * 1024 + (lane + 64 * i) * 4); pb[u][i] = *(const u32x2*)(P + (size_t)T * 1024 + (size_t)row * 1024 + (lane + 64 * i) * 4); } } }
#pragma unroll
            for (int u = 0; u < 2; ++u) { const int row = rowb + u * stride; if (row < T) {
#pragma unroll
                for (int i = 0; i < 4; ++i) { const u32x2 a = pa[u][i], b = pb[u][i]; f32x4 s4;
                    s4[0] = __uint_as_float(a[0] << 16) + __uint_as_float(b[0] << 16); s4[1] = __uint_as_float(a[0] & 0xFFFF0000u) + __uint_as_float(b[0] & 0xFFFF0000u);
                    s4[2] = __uint_as_float(a[1] << 16) + __uint_as_float(b[1] << 16); s4[3] = __uint_as_float(a[1] & 0xFFFF0000u) + __uint_as_float(b[1] & 0xFFFF0000u);
                    v[u][i] += g[u][i] * s4; } } }
        }
        f32x4 sh[2][4], sc[2][4];
#pragma unroll
        for (int u = 0; u < 2; ++u) { const int row = rowb + u * stride; if (row < T) {
            if (which == 2) {
#pragma unroll
                for (int i = 0; i < 4; ++i) sc[u][i] = ((const f32x4*)p.in[38])[lane + 64 * i]; }
            else { const float* m = MOD + ((size_t)l * 3 + cvec_of(row)) * 6144 + which * 3072;
#pragma unroll
                for (int i = 0; i < 4; ++i) { sh[u][i] = ((const f32x4*)m)[lane + 64 * i]; sc[u][i] = ((const f32x4*)(m + 1024))[lane + 64 * i]; } } } }
#pragma unroll
        for (int u = 0; u < 2; ++u) { const int row = rowb + u * stride; if (row < T) { float ss = 0.f;
#pragma unroll
            for (int i = 0; i < 4; ++i) ss += v[u][i][0] * v[u][i][0] + v[u][i][1] * v[u][i][1] + v[u][i][2] * v[u][i][2] + v[u][i][3] * v[u][i][3];
            ss = wave_sum(ss); rstd[u] = rsqrtf(ss * (1.0f / 1024.0f) + EPS); } }
#pragma unroll
        for (int u = 0; u < 2; ++u) { const int row = rowb + u * stride; if (row < T) {
            if (which != 2 || true) { if (which != 2) { f32x4* xr = (f32x4*)(X + (size_t)row * 1024);
#pragma unroll
                for (int i = 0; i < 4; ++i) xr[lane + 64 * i] = v[u][i]; } }
            if (which == 2) { float* o = p.out + (row < 4096 ? O_YP + (size_t)row * 1024 : O_YS + (size_t)(row - 4096) * 1024);
#pragma unroll
                for (int i = 0; i < 4; ++i) ((f32x4*)o)[lane + 64 * i] = v[u][i] * rstd[u] * sc[u][i]; }
            else {
#pragma unroll
                for (int i = 0; i < 4; ++i) { const f32x4 hv = v[u][i] * rstd[u] * (sc[u][i] + 1.0f) + sh[u][i]; u32x2 o; o[0] = pk2(hv[0], hv[1]); o[1] = pk2(hv[2], hv[3]);
                    *(u32x2*)(H + (size_t)row * 1024 + (lane + 64 * i) * 4) = o; } } } }
    }
}

__device__ __forceinline__ void phase_zgemm(PRef p, int j, unsigned char* shm) {
    const int t = tidx(), lane = t & 63, wv = t >> 6, r = lane & 31, h = lane >> 5;
    const bf16_t* H = (const bf16_t*)(p.ws + WS_H); const bf16_t* WZ = (const bf16_t*)(p.ws + WS_WZ) + (size_t)j * 32 * 1024; float* ZG = (float*)(p.ws + WS_ZG);
    float* red = (float*)shm;
    for (int tile = bidx(); tile < T / 32; tile += gdim()) {
        f32x16 acc = zero16();
        const bf16_t* a = H + (size_t)(tile * 32 + r) * 1024 + wv * 128 + 8 * h; const bf16_t* b = WZ + (size_t)r * 1024 + wv * 128 + 8 * h;
        bf16x8 av[8], bv[8];
#pragma unroll
        for (int ks = 0; ks < 8; ++ks) { av[ks] = *(const bf16x8*)(a + ks * 16); bv[ks] = *(const bf16x8*)(b + ks * 16); }
#pragma unroll
        for (int ks = 0; ks < 8; ++ks) acc = mfma32(av[ks], bv[ks], acc);
#pragma unroll
        for (int q = 0; q < 16; ++q) red[(wv * 16 + q) * 64 + lane] = acc[q];
        __syncthreads();
        for (int e = t; e < 1024; e += 512) { const int q = e >> 6, ln = e & 63; float s2 = 0.f;
#pragma unroll
            for (int w = 0; w < 8; ++w) s2 += red[(w * 16 + q) * 64 + ln];
            const int row = tile * 32 + (q & 3) + 8 * (q >> 2) + 4 * (ln >> 5); ZG[(size_t)row * 32 + (ln & 31)] = s2; }
        __syncthreads();
    }
}

__device__ __forceinline__ int seq_base(int s) { return s < 16 ? s * 256 : 4096 + (s - 16) * 1024; }
__device__ __forceinline__ int gla_item(int s, int h, int c, int dir) { return s < 16 ? ((s * 4 + h) * 4 + c) * 2 + dir : 512 + (((s - 16) * 4 + h) * 16 + c) * 2 + dir; }
constexpr int GLD = 72;

__device__ __forceinline__ void gla_gates(PRef p, int j, int h, int dir, int tok0, float* ZL, float* PT, float (&b)[8], float& blast) {
    const int t = tidx(), d = t & 63, g8 = t >> 6;
    const float* ZG = (const float*)(p.ws + WS_ZG);
    for (int e = t; e < 1024; e += 512) { const int ip = e >> 4, jz = e & 15; const int tok = tok0 + (dir ? 63 - ip : ip); ZL[e] = ZG[(size_t)tok * 32 + dir * 16 + jz]; }
    __syncthreads();
    const float* wg_ = p.in[dir ? 15 : 13] + (size_t)j * 16 * 256 + h * 64 + d;
    float w[16];
#pragma unroll
    for (int q = 0; q < 16; ++q) w[q] = wg_[q * 256];
    const float bias = p.in[dir ? 16 : 14][j * 256 + h * 64 + d];
    float run = 0.f;
#pragma unroll
    for (int ii = 0; ii < 8; ++ii) { const int ip = g8 * 8 + ii; float x = bias;
#pragma unroll
        for (int q = 0; q < 16; ++q) x += ZL[ip * 16 + q] * w[q];
        const float ls = fminf(x, 0.f) - log1pf(__expf(-fabsf(x)));
        run += ls * (1.0f / 16.0f); b[ii] = run; }
    PT[g8 * 64 + d] = run;
    __syncthreads();
    float off = 0.f, tot = 0.f;
#pragma unroll
    for (int g = 0; g < 8; ++g) { const float v = PT[g * 64 + d]; tot += v; if (g < g8) off += v; }
#pragma unroll
    for (int ii = 0; ii < 8; ++ii) b[ii] += off;
    blast = tot;
    __syncthreads();
}
__device__ __forceinline__ void gla_load_vt(const bf16_t* PROJ, int h, int dir, int tok0, bf16_t* VTL) {
    const int t = tidx(), e = t & 127, grp = t >> 7;
    unsigned pk[8];
#pragma unroll
    for (int q = 0; q < 8; ++q) { const int i0 = grp * 16 + 2 * q; const int tk0 = tok0 + (dir ? 63 - i0 : i0), tk1 = tok0 + (dir ? 62 - i0 : i0 + 1);
        const unsigned lo = PROJ[(size_t)tk0 * 2560 + 512 + h * 128 + e], hi = PROJ[(size_t)tk1 * 2560 + 512 + h * 128 + e]; pk[q] = lo | (hi << 16); }
    u32x4 o0, o1; o0[0] = pk[0]; o0[1] = pk[1]; o0[2] = pk[2]; o0[3] = pk[3]; o1[0] = pk[4]; o1[1] = pk[5]; o1[2] = pk[6]; o1[3] = pk[7];
    *(u32x4*)(VTL + e * GLD + grp * 16) = o0; *(u32x4*)(VTL + e * GLD + grp * 16 + 8) = o1;
}

__device__ __forceinline__ void gla_pass_a(PRef p, int j, int item, unsigned char* shm) {
    int s, h, c, dir;
    if (item < 512) { s = item >> 5; const int rem = item & 31; h = rem >> 3; c = (rem & 7) >> 1; dir = rem & 1; }
    else { const int it = item - 512; s = 16 + (it >> 7); const int rem = it & 127; h = rem >> 5; c = (rem & 31) >> 1; dir = rem & 1; }
    const int tok0 = seq_base(s) + 64 * c;
    bf16_t* KTL = (bf16_t*)shm;
    bf16_t* VTL = KTL + 64 * GLD;
    float* ZL = (float*)(VTL + 128 * GLD);
    float* PT = ZL + 1024;
    const bf16_t* PROJ = (const bf16_t*)(p.ws + WS_PROJ);
    float* DS = (float*)(p.ws + WS_DS) + (size_t)item * 8192; float* DEC = (float*)(p.ws + WS_DEC) + (size_t)item * 64;
    const int t = tidx(), d = t & 63, g8 = t >> 6;
    bf16_t kr[8];
#pragma unroll
    for (int ii = 0; ii < 8; ++ii) { const int ip = g8 * 8 + ii; const int tok = tok0 + (dir ? 63 - ip : ip); kr[ii] = PROJ[(size_t)tok * 2560 + 256 + h * 64 + d]; }
    gla_load_vt(PROJ, h, dir, tok0, VTL);
    float b[8], blast;
    gla_gates(p, j, h, dir, tok0, ZL, PT, b, blast);
    { unsigned pk[4];
#pragma unroll
      for (int q = 0; q < 4; ++q) pk[q] = pk2(bf2f(kr[2 * q]) * __expf(blast - b[2 * q]), bf2f(kr[2 * q + 1]) * __expf(blast - b[2 * q + 1]));
      u32x4 o; o[0] = pk[0]; o[1] = pk[1]; o[2] = pk[2]; o[3] = pk[3];
      *(u32x4*)(KTL + d * GLD + g8 * 8) = o; }
    if (t < 64) DEC[t] = __expf(blast);
    __syncthreads();
    { const int wv = t >> 6, lane = t & 63, mt = wv >> 2, nt = wv & 3, hh = lane >> 5, r = lane & 31;
      f32x16 acc = mma_rows(KTL + mt * 32 * GLD, GLD, VTL + nt * 32 * GLD, GLD, 64, zero16());
#pragma unroll
      for (int q = 0; q < 16; ++q) { const int dd = 32 * mt + (q & 3) + 8 * (q >> 2) + 4 * hh; DS[dd * 128 + 32 * nt + r] = acc[q]; } }
    __syncthreads();
}

__device__ __forceinline__ void gla_pass_b(PRef p, int j, int item, unsigned char* shm) {
    int s, h, c, nC;
    if (item < 256) { s = item >> 4; h = (item >> 2) & 3; c = item & 3; nC = 4; }
    else { const int it = item - 256; s = 16 + (it >> 6); h = (it >> 4) & 3; c = it & 15; nC = 16; }
    const int tok0 = seq_base(s) + 64 * c;
    float* OL = (float*)shm;
    bf16_t* QL = (bf16_t*)(OL + 64 * 132);
    bf16_t* KL = QL + 64 * GLD;
    bf16_t* PL = KL + 64 * GLD;
    bf16_t* VTL = PL + 64 * GLD;
    bf16_t* STL = VTL + 128 * GLD;
    float* ZL = (float*)(STL + 128 * GLD);
    float* PT = ZL + 1024;
    const bf16_t* PROJ = (const bf16_t*)(p.ws + WS_PROJ);
    const float* DSb = (const float*)(p.ws + WS_DS); const float* DECb = (const float*)(p.ws + WS_DEC);
    const int t = tidx(), d = t & 63, g8 = t >> 6, wv = t >> 6, lane = t & 63;
    bf16_t ra0[8], ra1[8];
#pragma unroll
    for (int q = 0; q < 8; ++q) { const int tok = tok0 + wv * 8 + q; ra0[q] = PROJ[(size_t)tok * 2560 + 1024 + h * 128 + lane]; ra1[q] = PROJ[(size_t)tok * 2560 + 1024 + h * 128 + 64 + lane]; }
    for (int dir = 0; dir < 2; ++dir) {
        bf16_t qr[8], kr[8];
#pragma unroll
        for (int ii = 0; ii < 8; ++ii) { const int ip = g8 * 8 + ii; const int tok = tok0 + (dir ? 63 - ip : ip);
            qr[ii] = PROJ[(size_t)tok * 2560 + h * 64 + d]; kr[ii] = PROJ[(size_t)tok * 2560 + 256 + h * 64 + d]; }
        gla_load_vt(PROJ, h, dir, tok0, VTL);
        { const int e = t & 127, dg = t >> 7; float S[16];
          if (s >= 16) { const float* st = p.in[dir ? 3 : 2] + ((size_t)((s - 16) * 2 + j) * 4 + h) * 8192;
#pragma unroll
              for (int i = 0; i < 16; ++i) S[i] = st[(dg * 16 + i) * 128 + e]; }
          else {
#pragma unroll
              for (int i = 0; i < 16; ++i) S[i] = 0.f; }
          const int nprev = dir ? nC - 1 - c : c;
#pragma unroll 2
          for (int q = 0; q < nprev; ++q) { const int cc = dir ? nC - 1 - q : q; const int it = gla_item(s, h, cc, dir);
              const float* ds = DSb + (size_t)it * 8192 + (size_t)(dg * 16) * 128 + e; const f32x4* dc4 = (const f32x4*)(DECb + (size_t)it * 64 + dg * 16);
              float dv[16]; f32x4 dcv[4];
#pragma unroll
              for (int i = 0; i < 4; ++i) dcv[i] = dc4[i];
#pragma unroll
              for (int i = 0; i < 16; ++i) dv[i] = ds[i * 128];
#pragma unroll
              for (int i = 0; i < 16; ++i) S[i] = S[i] * dcv[i >> 2][i & 3] + dv[i]; }
          u32x4 o0, o1;
          o0[0] = pk2(S[0], S[1]); o0[1] = pk2(S[2], S[3]); o0[2] = pk2(S[4], S[5]); o0[3] = pk2(S[6], S[7]);
          o1[0] = pk2(S[8], S[9]); o1[1] = pk2(S[10], S[11]); o1[2] = pk2(S[12], S[13]); o1[3] = pk2(S[14], S[15]);
          *(u32x4*)(STL + e * GLD + dg * 16) = o0; *(u32x4*)(STL + e * GLD + dg * 16 + 8) = o1;
          if (s < 16 && ((dir == 0 && c == nC - 1) || (dir == 1 && c == 0))) {
              const int it = gla_item(s, h, c, dir); const float* ds = DSb + (size_t)it * 8192; const float* dc = DECb + (size_t)it * 64;
              float* o = p.out + (dir ? O_SB : O_SF) + ((size_t)(s * 2 + j) * 4 + h) * 8192;
#pragma unroll
              for (int i = 0; i < 16; ++i) o[(dg * 16 + i) * 128 + e] = S[i] * dc[dg * 16 + i] + ds[(dg * 16 + i) * 128 + e]; } }
        float b[8], blast;
        gla_gates(p, j, h, dir, tok0, ZL, PT, b, blast);
#pragma unroll
        for (int ii = 0; ii < 8; ++ii) { const int ip = g8 * 8 + ii;
            const float qv = bf2f(qr[ii]) * 0.125f * __expf(b[ii]);
            const float kv = bf2f(kr[ii]) * __expf(-b[ii]);
            QL[ip * GLD + d] = f2bf(qv); KL[ip * GLD + d] = f2bf(kv); }
        __syncthreads();
        const int hh = lane >> 5, r = lane & 31;
        if (wv < 4) { const int mt = wv >> 1, nt = wv & 1;
            f32x16 sc = mma_rows(QL + mt * 32 * GLD, GLD, KL + nt * 32 * GLD, GLD, 64, zero16());
#pragma unroll
            for (int q = 0; q < 16; ++q) { const int ip = 32 * mt + (q & 3) + 8 * (q >> 2) + 4 * hh, jp = 32 * nt + r; PL[ip * GLD + jp] = f2bf(jp <= ip ? sc[q] : 0.f); } }
        const int mt = wv >> 2, nt = wv & 3;
        f32x16 acc = mma_rows(QL + mt * 32 * GLD, GLD, STL + nt * 32 * GLD, GLD, 64, zero16());
        __syncthreads();
        acc = mma_rows(PL + mt * 32 * GLD, GLD, VTL + nt * 32 * GLD, GLD, 64, acc);
#pragma unroll
        for (int q = 0; q < 16; ++q) { const int ip = 32 * mt + (q & 3) + 8 * (q >> 2) + 4 * hh; const int pp = dir ? 63 - ip : ip; float* o = OL + pp * 132 + 32 * nt + r;
            if (dir == 0) *o = acc[q]; else *o += acc[q]; }
        __syncthreads();
    }
    bf16_t* MIX = (bf16_t*)(p.ws + WS_MIX);
    const float g0 = p.in[17][j * 128 + lane], g1 = p.in[17][j * 128 + 64 + lane];
#pragma unroll
    for (int q = 0; q < 8; ++q) { const int pp = wv * 8 + q; const int tok = tok0 + pp;
        const float v0 = OL[pp * 132 + lane], v1 = OL[pp * 132 + 64 + lane];
        const float ss = wave_sum(v0 * v0 + v1 * v1); const float rstd = rsqrtf(ss * (1.0f / 128.0f) + EPS);
        const float r0 = bf2f(ra0[q]), r1 = bf2f(ra1[q]);
        MIX[(size_t)tok * 1024 + h * 128 + lane] = f2bf(v0 * rstd * g0 * silu_f(r0));
        MIX[(size_t)tok * 1024 + h * 128 + 64 + lane] = f2bf(v1 * rstd * g1 * silu_f(r1)); }
    __syncthreads();
}

__device__ __forceinline__ void gqa_prep(PRef p, int j, int rb, unsigned char* shm) {
    const int t = tidx(), lane = t & 63, wv = t >> 6;
    const int r0 = rb * 64;
    const bf16_t* PROJ = (const bf16_t*)(p.ws + WS_PROJ);
    bf16_t* QNG = (bf16_t*)(p.ws + WS_QNG); bf16_t* KNG = (bf16_t*)(p.ws + WS_KNG); bf16_t* VTG = (bf16_t*)(p.ws + WS_VTG);
    bf16_t* VL = (bf16_t*)shm;
    const bool ctx = r0 >= T;
    if (!ctx) {
        const float gq0 = p.in[18][j * 128 + lane], gq1 = p.in[18][j * 128 + 64 + lane], gk0 = p.in[19][j * 128 + lane], gk1 = p.in[19][j * 128 + 64 + lane];
        const float inv = exp2f(-(float)(lane & 31) * (13.287712379549449f / 32.0f));
        for (int hb = 0; hb < 6; ++hb) {
            bf16_t r1[8], r2[8];
#pragma unroll
            for (int u = 0; u < 8; ++u) { const int hv = wv * 48 + hb * 8 + u; const int row = r0 + hv / 6, which = hv % 6; const int col = which < 4 ? 1536 + which * 128 : 2048 + (which - 4) * 128;
                r1[u] = PROJ[(size_t)row * 2560 + col + lane]; r2[u] = PROJ[(size_t)row * 2560 + col + 64 + lane]; }
#pragma unroll
            for (int u = 0; u < 8; ++u) { const int hv = wv * 48 + hb * 8 + u; const int row = r0 + hv / 6, which = hv % 6;
                float x1 = bf2f(r1[u]), x2 = bf2f(r2[u]);
                const float ss = wave_sum(x1 * x1 + x2 * x2); const float rstd = rsqrtf(ss * (1.0f / 128.0f) + EPS);
                x1 = x1 * rstd * (which < 4 ? gq0 : gk0); x2 = x2 * rstd * (which < 4 ? gq1 : gk1);
                if (row < 4096) {
                    if (which >= 4) { const int b = row >> 8, tt = row & 255; float* o = p.out + O_CK + ((size_t)(b * 2 + j) * 256 + tt) * 256 + (which - 4) * 128; o[lane] = x1; o[64 + lane] = x2; }
                } else { const int tt = (row - 4096) & 1023; const float pos = lane < 32 ? (float)(tt >> 6) : (float)(tt & 63); const float ang = pos * inv;
                    const float cs = __cosf(ang), sn = __sinf(ang); const float y1 = x1 * cs - x2 * sn, y2 = x1 * sn + x2 * cs; x1 = y1; x2 = y2; }
                if (which < 4) { QNG[(size_t)row * 512 + which * 128 + lane] = f2bf(x1); QNG[(size_t)row * 512 + which * 128 + 64 + lane] = f2bf(x2); }
                else { KNG[(size_t)row * 256 + (which - 4) * 128 + lane] = f2bf(x1); KNG[(size_t)row * 256 + (which - 4) * 128 + 64 + lane] = f2bf(x2); } } }
        { u32x4 vv[4];
#pragma unroll
          for (int i = 0; i < 4; ++i) { const int c = t + 512 * i, rr = c >> 5, piece = c & 31; vv[i] = *(const u32x4*)(PROJ + (size_t)(r0 + rr) * 2560 + 2304 + piece * 8); }
#pragma unroll
          for (int i = 0; i < 4; ++i) { const int c = t + 512 * i, rr = c >> 5, piece = c & 31; const int row = r0 + rr;
              *(u32x4*)(VL + rr * 264 + piece * 8) = vv[i];
              if (row < 4096) { const int b = row >> 8, tt = row & 255; float* o = p.out + O_CV + ((size_t)(b * 2 + j) * 256 + tt) * 256 + piece * 8;
                  f32x4 o0, o1; o0[0] = __uint_as_float(vv[i][0] << 16); o0[1] = __uint_as_float(vv[i][0] & 0xFFFF0000u); o0[2] = __uint_as_float(vv[i][1] << 16); o0[3] = __uint_as_float(vv[i][1] & 0xFFFF0000u);
                  o1[0] = __uint_as_float(vv[i][2] << 16); o1[1] = __uint_as_float(vv[i][2] & 0xFFFF0000u); o1[2] = __uint_as_float(vv[i][3] << 16); o1[3] = __uint_as_float(vv[i][3] & 0xFFFF0000u);
                  *(f32x4*)o = o0; *(f32x4*)(o + 4) = o1; } } }
    } else {
        f32x4 kk[4][2], vv[4][2];
#pragma unroll
        for (int i = 0; i < 4; ++i) { const int c = t + 512 * i, rr = c >> 5, piece = c & 31; const int row = r0 + rr; const int b = (row - T) >> 9, pp = (row - T) & 511;
            const size_t ci = ((size_t)(b * 2 + j) * 512 + pp) * 256 + piece * 8;
            kk[i][0] = *(const f32x4*)(p.in[4] + ci); kk[i][1] = *(const f32x4*)(p.in[4] + ci + 4); vv[i][0] = *(const f32x4*)(p.in[5] + ci); vv[i][1] = *(const f32x4*)(p.in[5] + ci + 4); }
#pragma unroll
        for (int i = 0; i < 4; ++i) { const int c = t + 512 * i, rr = c >> 5, piece = c & 31; const int row = r0 + rr;
            u32x4 ko, vo; ko[0] = pk2(kk[i][0][0], kk[i][0][1]); ko[1] = pk2(kk[i][0][2], kk[i][0][3]); ko[2] = pk2(kk[i][1][0], kk[i][1][1]); ko[3] = pk2(kk[i][1][2], kk[i][1][3]);
            vo[0] = pk2(vv[i][0][0], vv[i][0][1]); vo[1] = pk2(vv[i][0][2], vv[i][0][3]); vo[2] = pk2(vv[i][1][0], vv[i][1][1]); vo[3] = pk2(vv[i][1][2], vv[i][1][3]);
            *(u32x4*)(KNG + (size_t)row * 256 + piece * 8) = ko; *(u32x4*)(VL + rr * 264 + piece * 8) = vo; }
    }
    __syncthreads();
    { const int gd = t & 255, half = t >> 8; unsigned pk[16];
#pragma unroll
      for (int q = 0; q < 16; ++q) { const unsigned lo = VL[(half * 32 + 2 * q) * 264 + gd], hi = VL[(half * 32 + 2 * q + 1) * 264 + gd]; pk[q] = lo | (hi << 16); }
      bf16_t* dst = VTG + (size_t)gd * TK + r0 + half * 32;
#pragma unroll
      for (int q = 0; q < 4; ++q) { u32x4 o; o[0] = pk[4 * q]; o[1] = pk[4 * q + 1]; o[2] = pk[4 * q + 2]; o[3] = pk[4 * q + 3]; *(u32x4*)(dst + 8 * q) = o; } }
    __syncthreads();
}

template <int KS1, int KS2>
__device__ __forceinline__ void attn_wg(const bf16_t* K1, int ld1, const bf16_t* K2, int ld2, const bf16x8 (&bq)[KS1 + KS2], const bf16_t* VT, int ldvt,
                                        int seg0_base, int seg0_tiles, int seg1_base, int tpq, float sc2, bf16_t* out, int ldo, unsigned char* shm) {
    constexpr int KLD = (KS1 + KS2) * 16 + 8, VLD = 36, KTILE = 32 * KLD, VTILE = 128 * VLD;
    bf16_t* Kl = (bf16_t*)shm; bf16_t* Vl = Kl + 4 * KTILE;
    const int t = tidx(), wv = t >> 6, lane = t & 63, r = lane & 31, h = lane >> 5, qblk = wv & 1, kq = wv >> 1;
    f32x16 oacc[4];
#pragma unroll
    for (int i = 0; i < 4; ++i) oacc[i] = zero16();
    float m = -1e30f, l = 0.f;
    u32x4 rk1[4], rk2[2], rv[4];
#define ATT_KB(q_, st_) ({ const int Tt_ = (q_) * tpq + (st_); Tt_ < seg0_tiles ? seg0_base + 32 * Tt_ : seg1_base + 32 * (Tt_ - seg0_tiles); })
#define ATT_LOAD(st_) do { \
        _Pragma("unroll") for (int i_ = 0; i_ < 4; ++i_) { const int kb_ = ATT_KB(i_, st_); \
            rk1[i_] = *(const u32x4*)(K1 + (size_t)(kb_ + (t >> 4)) * ld1 + (t & 15) * 8); \
            rv[i_] = *(const u32x4*)(VT + (size_t)(t >> 2) * ldvt + kb_ + (t & 3) * 8); } \
        if (KS2 > 0) { _Pragma("unroll") for (int i_ = 0; i_ < 2; ++i_) { const int kb_ = ATT_KB((t >> 8) + 2 * i_, st_); \
            rk2[i_] = *(const u32x4*)(K2 + (size_t)(kb_ + ((t & 255) >> 3)) * ld2 + (t & 7) * 8); } } } while (0)
    ATT_LOAD(0);
    for (int st = 0; st < tpq; ++st) {
#pragma unroll
        for (int i = 0; i < 4; ++i) { *(u32x4*)(Kl + i * KTILE + (t >> 4) * KLD + (t & 15) * 8) = rk1[i];
            bf16_t* vd = Vl + i * VTILE + (t >> 2) * VLD + (t & 3) * 8; u32x2 a, b; a[0] = rv[i][0]; a[1] = rv[i][1]; b[0] = rv[i][2]; b[1] = rv[i][3]; *(u32x2*)vd = a; *(u32x2*)(vd + 4) = b; }
        if (KS2 > 0) {
#pragma unroll
            for (int i = 0; i < 2; ++i) *(u32x4*)(Kl + ((t >> 8) + 2 * i) * KTILE + ((t & 255) >> 3) * KLD + KS1 * 16 + (t & 7) * 8) = rk2[i]; }
        __syncthreads();
        if (st + 1 < tpq) ATT_LOAD(st + 1);
        f32x16 s = zero16();
        { const bf16_t* kp = Kl + kq * KTILE + r * KLD + 8 * h;
#pragma unroll
          for (int ks = 0; ks < KS1 + KS2; ++ks) s = mfma32(*(const bf16x8*)(kp + ks * 16), bq[ks], s); }
        float tmax = s[0];
#pragma unroll
        for (int q = 1; q < 16; ++q) tmax = fmaxf(tmax, s[q]);
        tmax = fmaxf(tmax, __shfl_xor(tmax, 32, 64));
        const float mnew = fmaxf(m, tmax); const float alpha = __builtin_amdgcn_exp2f((m - mnew) * sc2); const float mb = mnew * sc2;
        float pr[16]; float rs = 0.f;
#pragma unroll
        for (int q = 0; q < 16; ++q) { pr[q] = __builtin_amdgcn_exp2f(s[q] * sc2 - mb); rs += pr[q]; }
        l = l * alpha + rs; m = mnew;
#pragma unroll
        for (int i = 0; i < 4; ++i) oacc[i] *= alpha;
        bf16x8 pb[2];
#pragma unroll
        for (int si = 0; si < 2; ++si) { u32x4 w; w[0] = pk2(pr[8 * si], pr[8 * si + 1]); w[1] = pk2(pr[8 * si + 2], pr[8 * si + 3]); w[2] = pk2(pr[8 * si + 4], pr[8 * si + 5]); w[3] = pk2(pr[8 * si + 6], pr[8 * si + 7]);
            pb[si] = __builtin_bit_cast(bf16x8, w); }
#pragma unroll
        for (int dt = 0; dt < 4; ++dt) { const bf16_t* vp = Vl + kq * VTILE + (dt * 32 + r) * VLD + 4 * h;
#pragma unroll
            for (int si = 0; si < 2; ++si) { const u32x2 lo = *(const u32x2*)(vp + 16 * si), hi = *(const u32x2*)(vp + 16 * si + 8);
                u32x4 w; w[0] = lo[0]; w[1] = lo[1]; w[2] = hi[0]; w[3] = hi[1];
                oacc[dt] = mfma32(__builtin_bit_cast(bf16x8, w), pb[si], oacc[dt]); } }
        __syncthreads();
    }
#undef ATT_LOAD
#undef ATT_KB
    float* OC = (float*)shm;
    float* ML = OC + 8 * 64 * 64;
    const float ltot = l + __shfl_xor(l, 32, 64);
    ML[(wv * 2 + 0) * 64 + lane] = m; ML[(wv * 2 + 1) * 64 + lane] = ltot;
    { float* oc = OC + (size_t)wv * 4096 + lane;
#pragma unroll
      for (int dt = 0; dt < 4; ++dt)
#pragma unroll
          for (int q = 0; q < 16; ++q) oc[(dt * 16 + q) * 64] = oacc[dt][q]; }
    __syncthreads();
    { float mk[4], lk[4]; float M = -1e30f;
#pragma unroll
      for (int k = 0; k < 4; ++k) { mk[k] = ML[((k * 2 + qblk) * 2 + 0) * 64 + lane]; lk[k] = ML[((k * 2 + qblk) * 2 + 1) * 64 + lane]; M = fmaxf(M, mk[k]); }
      float sk[4]; float L = 0.f;
#pragma unroll
      for (int k = 0; k < 4; ++k) { sk[k] = __builtin_amdgcn_exp2f((mk[k] - M) * sc2); L += sk[k] * lk[k]; }
      const float inv = 1.0f / L; const int dt = kq;
      float o[16];
#pragma unroll
      for (int q = 0; q < 16; ++q) { float v = 0.f;
#pragma unroll
          for (int k = 0; k < 4; ++k) v += sk[k] * OC[(size_t)(k * 2 + qblk) * 4096 + (dt * 16 + q) * 64 + lane];
          o[q] = v * inv; }
#pragma unroll
      for (int rg = 0; rg < 4; ++rg) { u32x2 w; w[0] = pk2(o[4 * rg], o[4 * rg + 1]); w[1] = pk2(o[4 * rg + 2], o[4 * rg + 3]);
          *(u32x2*)(out + (size_t)(qblk * 32 + r) * ldo + dt * 32 + 8 * rg + 4 * h) = w; } }
    __syncthreads();
}

__device__ __forceinline__ void gqa_attn_item(PRef p, int a, unsigned char* shm) {
    const int wv = tidx() >> 6, lane = tidx() & 63, r = lane & 31, h = lane >> 5;
    int hq, q0, s0b, s0t, s1b, tpq;
    if (a < 128) { const int b = a >> 6; hq = (a >> 4) & 3; const int qb = a & 15; q0 = 4096 + b * 1024 + qb * 64; s0b = T + b * 512; s0t = 16; s1b = 4096 + b * 1024; tpq = 12; }
    else { const int aa = a - 128; const int b = aa >> 4; hq = (aa >> 2) & 3; const int qb = aa & 3; q0 = b * 256 + qb * 64; s0b = b * 256; s0t = 8; s1b = 0; tpq = 2; }
    const int g = hq >> 1;
    const bf16_t* QNG = (const bf16_t*)(p.ws + WS_QNG); const bf16_t* KNG = (const bf16_t*)(p.ws + WS_KNG); const bf16_t* VTG = (const bf16_t*)(p.ws + WS_VTG);
    bf16_t* MIX = (bf16_t*)(p.ws + WS_MIX);
    bf16x8 bq[8];
    const bf16_t* qp = QNG + (size_t)(q0 + (wv & 1) * 32 + r) * 512 + hq * 128 + 8 * h;
#pragma unroll
    for (int ks = 0; ks < 8; ++ks) bq[ks] = *(const bf16x8*)(qp + ks * 16);
    attn_wg<8, 0>(KNG + g * 128, 256, nullptr, 0, bq, VTG + (size_t)g * 128 * TK, TK, s0b, s0t, s1b, tpq, 0.08838834764831845f * 1.4426950408889634f,
                  MIX + (size_t)q0 * 1024 + 512 + hq * 128, 1024, shm);
}
__device__ __forceinline__ void mla_attn_item(PRef p, int j, int a, unsigned char* shm) {
    const int wv = tidx() >> 6, lane = tidx() & 63, r = lane & 31, h = lane >> 5;
    int hd, q0, s0b, s0t, s1b, tpq; bool samp;
    if (a < 128) { const int b = a >> 6; hd = (a >> 4) & 3; const int qb = a & 15; q0 = 4096 + b * 1024 + qb * 64; s0b = T + b * 512; s0t = 16; s1b = 4096 + b * 1024; tpq = 12; samp = true; }
    else { const int aa = a - 128; const int b = aa >> 4; hd = (aa >> 2) & 3; const int qb = aa & 3; q0 = b * 256 + qb * 64; s0b = b * 256; s0t = 8; s1b = 0; tpq = 2; samp = false; }
    const bf16_t* QM = (const bf16_t*)(p.ws + WS_QMLA); const bf16_t* KN = (const bf16_t*)(p.ws + WS_KNOPE); const bf16_t* KPE = (const bf16_t*)(p.ws + WS_KPE) + (size_t)j * TK * 64;
    const bf16_t* VTM = (const bf16_t*)(p.ws + WS_VTM); bf16_t* MIX = (bf16_t*)(p.ws + WS_MIX);
    bf16x8 bq[12];
    const int qrow = q0 + (wv & 1) * 32 + r;
    const bf16_t* qp = QM + (size_t)qrow * 768 + hd * 192 + 8 * h;
#pragma unroll
    for (int ks = 0; ks < 12; ++ks) bq[ks] = *(const bf16x8*)(qp + ks * 16);
    if (samp) { const int tt = (qrow - 4096) & 1023; const float prow = (float)(tt >> 6), pcol = (float)(tt & 63);
#pragma unroll
        for (int ksp = 0; ksp < 2; ++ksp) { bf16x8 x1 = bq[8 + ksp], x2 = bq[10 + ksp];
#pragma unroll
            for (int jj = 0; jj < 8; ++jj) { const int i = 16 * ksp + 8 * h + jj; const float inv = exp2f(-(float)(i & 15) * (13.287712379549449f / 16.0f)); const float ang = (i < 16 ? prow : pcol) * inv;
                const float cs = __cosf(ang), sn = __sinf(ang); const float a1 = bf2f((bf16_t)x1[jj]), a2 = bf2f((bf16_t)x2[jj]);
                x1[jj] = (short)f2bf(a1 * cs - a2 * sn); x2[jj] = (short)f2bf(a1 * sn + a2 * cs); }
            bq[8 + ksp] = x1; bq[10 + ksp] = x2; } }
    attn_wg<8, 4>(KN + hd * 128, 512, KPE, 64, bq, VTM + (size_t)hd * 128 * TK, TK, s0b, s0t, s1b, tpq, 0.07216878364870322f * 1.4426950408889634f,
                  MIX + (size_t)q0 * 1024 + 512 + hd * 128, 1024, shm);
}

__device__ __forceinline__ void odd_prep(PRef p, int j, int rb, unsigned char* shm) {
    const int t = tidx(), lane = t & 63, wv = t >> 6; const int r0 = rb * 16;
    const bf16_t* PROJ = (const bf16_t*)(p.ws + WS_PROJ);
    bf16_t* X0 = (bf16_t*)(p.ws + WS_X0); bf16_t* GV = (bf16_t*)(p.ws + WS_GV); bf16_t* GVT = (bf16_t*)(p.ws + WS_GVT);
    bf16_t* GL = (bf16_t*)shm;
    { const int ch = t; float w[3][3], bb[3];
      const int L = r0 < 4096 ? 256 : 1024; const int tt0 = r0 < 4096 ? (r0 & 255) : ((r0 - 4096) & 1023);
      bf16_t u[3][18];
#pragma unroll
      for (int part = 0; part < 3; ++part) { bb[part] = p.in[23][j * 1536 + part * 512 + ch];
#pragma unroll
          for (int tap = 0; tap < 3; ++tap) w[part][tap] = p.in[22][((size_t)j * 3 + tap) * 1536 + part * 512 + ch];
#pragma unroll
          for (int q = 0; q < 18; ++q) { const bool ok = (q == 0) ? (tt0 > 0) : ((q == 17) ? (tt0 + 16 < L) : true);
              u[part][q] = ok ? PROJ[(size_t)(r0 - 1 + q) * PLO + part * 512 + ch] : (bf16_t)0; } }
#pragma unroll
      for (int rr = 0; rr < 16; ++rr) { const int row = r0 + rr;
          float o[3];
#pragma unroll
          for (int part = 0; part < 3; ++part) o[part] = bf2f(u[part][rr]) * w[part][0] + bf2f(u[part][rr + 1]) * w[part][1] + bf2f(u[part][rr + 2]) * w[part][2] + bb[part];
          const bf16_t gvb = f2bf(o[1] * o[2]);
          X0[(size_t)row * 512 + ch] = f2bf(o[0]); GV[(size_t)row * 512 + ch] = gvb; GL[rr * 520 + ch] = gvb; } }
    __syncthreads();
    { const int ch = t; bf16_t* dst = GVT + (size_t)ch * T + r0;
#pragma unroll
      for (int q = 0; q < 2; ++q) { u32x4 o;
#pragma unroll
          for (int z = 0; z < 4; ++z) { const unsigned lo = GL[(8 * q + 2 * z) * 520 + ch], hi = GL[(8 * q + 2 * z + 1) * 520 + ch]; o[z] = lo | (hi << 16); }
          *(u32x4*)(dst + 8 * q) = o; } }
    bf16_t* CQN = (bf16_t*)(p.ws + WS_CQN); bf16_t* CKV = (bf16_t*)(p.ws + WS_CKV) + (size_t)j * TK * 256; bf16_t* KPE = (bf16_t*)(p.ws + WS_KPE) + (size_t)j * TK * 64;
    for (int rr = wv; rr < 16; rr += 8) { const int row = r0 + rr; const bf16_t* pr = PROJ + (size_t)row * PLO;
        { float v[4]; float ss = 0.f;
#pragma unroll
          for (int q = 0; q < 4; ++q) { v[q] = bf2f(pr[1536 + lane * 4 + q]); ss += v[q] * v[q]; }
          ss = wave_sum(ss); const float rstd = rsqrtf(ss * (1.0f / 256.0f) + EPS); const f32x4 g = *(const f32x4*)(p.in[31] + j * 256 + lane * 4);
          u32x2 o; o[0] = pk2(v[0] * rstd * g[0], v[1] * rstd * g[1]); o[1] = pk2(v[2] * rstd * g[2], v[3] * rstd * g[3]);
          *(u32x2*)(CQN + (size_t)row * 256 + lane * 4) = o; }
        { float v0 = bf2f(pr[1792 + lane * 2]), v1 = bf2f(pr[1792 + lane * 2 + 1]); const float ss = wave_sum(v0 * v0 + v1 * v1); const float rstd = rsqrtf(ss * (1.0f / 128.0f) + EPS);
          v0 = v0 * rstd * p.in[33][j * 128 + lane * 2]; v1 = v1 * rstd * p.in[33][j * 128 + lane * 2 + 1];
          *(unsigned*)(CKV + (size_t)row * 256 + lane * 2) = pk2(v0, v1);
          if (row < 4096) { const int b = row >> 8, tt = row & 255; float* o = p.out + O_CKV + ((size_t)(b * 2 + j) * 256 + tt) * 128 + lane * 2; o[0] = v0; o[1] = v1; } }
        { float v = bf2f(pr[1920 + lane]);
          if (row < 4096) { const int b = row >> 8, tt = row & 255; p.out[O_KPE + ((size_t)(b * 2 + j) * 256 + tt) * 64 + lane] = v; }
          else { const int tt = (row - 4096) & 1023; const float other = __shfl_xor(v, 32, 64); const int i = lane & 31;
              const float inv = exp2f(-(float)(i & 15) * (13.287712379549449f / 16.0f)); const float ang = (i < 16 ? (float)(tt >> 6) : (float)(tt & 63)) * inv; const float cs = __cosf(ang), sn = __sinf(ang);
              v = lane < 32 ? v * cs - other * sn : other * sn + v * cs; }
          KPE[(size_t)row * 64 + lane] = f2bf(v); } }
    __syncthreads();
}

__device__ __forceinline__ void hyena_conv(PRef p, int j, int type, int half, int cg8, unsigned char* shm) {
    const int t = tidx(), lane = t & 63, wv = t >> 6, r = lane & 31, h = lane >> 5;
    const int L = type ? 1024 : 256, nb = L >> 5, tbase = type ? 4096 : half * 2048;
    bf16_t* OUT = (bf16_t*)shm;
    bf16_t* GRL = (bf16_t*)(shm + 32768) + wv * 2048;
    bf16_t* GVL = (bf16_t*)(shm + 65536) + wv * 2048;
    bf16_t* ZR = (bf16_t*)(shm + 98304);
    const int ch = cg8 * 8 + wv;
    const bf16_t* gr = (const bf16_t*)(p.ws + WS_GR) + (size_t)j * 512 * 2560 + (type ? (size_t)512 * 512 : 0) + (size_t)ch * (2 * L);
    for (int i = lane; i < (2 * L) / 8; i += 64) *(u32x4*)(GRL + i * 8) = *(const u32x4*)(gr + i * 8);
    const bf16_t* gvt = (const bf16_t*)(p.ws + WS_GVT) + (size_t)ch * T + tbase;
    for (int i = lane; i < 256; i += 64) *(u32x4*)(GVL + i * 8) = *(const u32x4*)(gvt + i * 8);
    if (t < 8) ((unsigned*)ZR)[t] = 0u;
    __syncthreads();
    f32x16 acc[2];
    acc[0] = zero16(); acc[1] = zero16();
    int cola[2], colb[2];
#pragma unroll
    for (int nt = 0; nt < 2; ++nt) { const int n = 32 * nt + r; const int batch = n / nb, a = n % nb; cola[nt] = a; colb[nt] = batch * L + 8 * h; }
    for (int dl = -(nb - 1); dl <= nb - 1; ++dl) {
#pragma unroll
        for (int kk = 0; kk < 2; ++kk) {
            const int m0 = (L - 1) - (32 * dl + r - 16 * kk - 8 * h);
            bf16x8 af;
#pragma unroll
            for (int jj = 0; jj < 8; ++jj) af[jj] = (short)((const volatile LAS bf16_t*)(LAS bf16_t*)GRL)[m0 + jj];
#pragma unroll
            for (int nt = 0; nt < 2; ++nt) { const int ab = cola[nt] - dl;
                const bf16_t* bp = (ab >= 0 && ab < nb) ? GVL + colb[nt] + 32 * ab + 16 * kk : ZR;
                acc[nt] = mfma32(af, *(const bf16x8*)bp, acc[nt]); }
        }
    }
#pragma unroll
    for (int nt = 0; nt < 2; ++nt) { const int n = 32 * nt + r; const int batch = n / nb, a = n % nb;
#pragma unroll
        for (int q = 0; q < 16; ++q) { const int i = (q & 3) + 8 * (q >> 2) + 4 * h; OUT[(batch * L + 32 * a + i) * 8 + wv] = f2bf(acc[nt][q]); } }
    __syncthreads();
    const bf16_t* X0 = (const bf16_t*)(p.ws + WS_X0); const bf16_t* GV = (const bf16_t*)(p.ws + WS_GV); bf16_t* MIX = (bf16_t*)(p.ws + WS_MIX);
    float sk[8];
#pragma unroll
    for (int q = 0; q < 8; ++q) sk[q] = p.in[24][j * 512 + cg8 * 8 + q];
    for (int tl = t; tl < 2048; tl += 512) { const int row = tbase + tl;
        const bf16x8 y = *(const bf16x8*)(OUT + tl * 8), x0 = *(const bf16x8*)(X0 + (size_t)row * 512 + cg8 * 8), gv = *(const bf16x8*)(GV + (size_t)row * 512 + cg8 * 8);
        float o[8];
#pragma unroll
        for (int q = 0; q < 8; ++q) o[q] = bf2f((bf16_t)x0[q]) * (bf2f((bf16_t)y[q]) + bf2f((bf16_t)gv[q]) * sk[q]);
        u32x4 w; w[0] = pk2(o[0], o[1]); w[1] = pk2(o[2], o[3]); w[2] = pk2(o[4], o[5]); w[3] = pk2(o[6], o[7]);
        *(u32x4*)(MIX + (size_t)row * 1024 + cg8 * 8) = w; }
    __syncthreads();
}

#define XB_TMO      128
#define XB_XCNT(j)  (256  + 64 * (j))
#define XB_XSUB(j)  (1280 + 64 * (j))
#define XB_XGEN(j)  (2304 + 64 * (j))
#define XB_TOP      3328
#define XB_TOPGEN   3392
#define XCD_BAR_WORDS 3456
#define XB_SPIN_CAP (1u << 22)
__device__ __forceinline__ unsigned xb_ld(unsigned* p)              { return __hip_atomic_load(p, __ATOMIC_RELAXED, __HIP_MEMORY_SCOPE_AGENT); }
__device__ __forceinline__ unsigned xb_add(unsigned* p, unsigned v) { return __hip_atomic_fetch_add(p, v, __ATOMIC_RELAXED, __HIP_MEMORY_SCOPE_AGENT); }
__device__ __forceinline__ unsigned xb_xcc_id() { return (unsigned)__builtin_amdgcn_s_getreg((3 << 11) | 20) & 0xFu; }
#define XB_SPIN(cond, bar) do { unsigned _sp = 0; while (cond) { __builtin_amdgcn_s_sleep(1); \
    if ((++_sp & 255u) == 0u) { if (xb_ld(&(bar)[XB_TMO])) break; if (_sp > XB_SPIN_CAP) { atomicAdd(&(bar)[XB_TMO], 1u); break; } } } } while (0)
struct XcdBarrier { unsigned* bar; unsigned x; volatile LAS unsigned* st; };
__device__ __forceinline__ XcdBarrier xcd_barrier_post(unsigned* bar, volatile LAS unsigned* st) {
    XcdBarrier b; b.bar = bar; b.x = xb_xcc_id(); b.st = st;
    if (threadIdx.x == 0) (void)xb_add(&bar[XB_XCNT(b.x)], 1u);
    return b;
}
__device__ __forceinline__ void xcd_barrier_complete(unsigned* bar, unsigned x, unsigned& nloc, unsigned& nx) {
    const unsigned G = gridDim.x * gridDim.y * gridDim.z;
    unsigned sum, cnt, mine, sp = 0u;
    for (;;) {
        sum = 0u; cnt = 0u; mine = 0u;
#pragma unroll
        for (unsigned j = 0; j < 16; ++j) { const unsigned c = xb_ld(&bar[XB_XCNT(j)]); sum += c; cnt += (c > 0u) ? 1u : 0u; mine = (j == x) ? c : mine; }
        if (sum == G) break;
        __builtin_amdgcn_s_sleep(1);
        if ((++sp & 255u) == 0u) { if (xb_ld(&bar[XB_TMO])) break; if (sp > XB_SPIN_CAP) { atomicAdd(&bar[XB_TMO], 1u); break; } }
    }
    nloc = mine > 0u ? mine : 1u; nx = cnt > 0u ? cnt : 1u;
}
__device__ __forceinline__ void xcd_barrier(const XcdBarrier& b) {
    asm volatile("s_waitcnt vmcnt(0)" ::: "memory");
    __syncthreads();
    if (threadIdx.x == 0) {
        unsigned* bar = b.bar;
        __builtin_amdgcn_s_waitcnt(0);
        unsigned nloc = b.st[0], nx = b.st[1];
        if (nloc == 0u) { xcd_barrier_complete(bar, b.x, nloc, nx); b.st[0] = nloc; b.st[1] = nx; }
        const unsigned old = xb_add(&bar[XB_XSUB(b.x)], 1u);
        const unsigned gen = old / nloc;
        const unsigned target = (gen + 1u) * nx;
        if (old + 1u == (gen + 1u) * nloc) {
            __builtin_amdgcn_fence(__ATOMIC_RELEASE, "agent");
            asm volatile("s_waitcnt vmcnt(0)" ::: "memory");
            xb_add(&bar[XB_TOP], 1u);
        }
        XB_SPIN(xb_ld(&bar[XB_TOP]) < target, bar);
        __builtin_amdgcn_fence(__ATOMIC_ACQUIRE, "agent");
        asm volatile("s_waitcnt vmcnt(0)" ::: "memory");
    }
    __syncthreads();
}

__device__ __forceinline__ int next_item(unsigned* q, volatile LAS unsigned* slot) {
    if (threadIdx.x == 0) *slot = __hip_atomic_fetch_add(q, 1u, __ATOMIC_RELAXED, __HIP_MEMORY_SCOPE_AGENT);
    __syncthreads();
    const int it = (int)*slot;
    __syncthreads();
    return it;
}

extern __shared__ __attribute__((aligned(16))) unsigned char g_shm[];

enum { K_PREP = 0, K_NORM, K_GS, K_E2, K_E3, K_O2, K_O4, K_GR_UNUSED, K_F1 };
__device__ __forceinline__ void decode_phase(int ph, int& kind, int& l, int& var) {
    if (ph == 0) { kind = K_PREP; l = 0; var = 0; return; }
    if (ph == N_PHASES - 1) { kind = K_NORM; l = 0; var = 2; return; }
    int q = ph - 1;
    if (q < 8) l = 0; else if (q < 17) { l = 1; q -= 8; } else if (q < 25) { l = 2; q -= 17; } else { l = 3; q -= 25; }
    if ((l & 1) == 0) {
        switch (q) { case 0: kind = K_NORM; var = 0; break; case 1: kind = K_GS; var = 0; break; case 2: kind = K_E2; var = 0; break; case 3: kind = K_E3; var = 0; break;
                     case 4: kind = K_GS; var = 3; break; case 5: kind = K_NORM; var = 1; break; case 6: kind = K_F1; var = 0; break; default: kind = K_GS; var = 4; break; }
    } else {
        switch (q) { case 0: kind = K_NORM; var = 0; break; case 1: kind = K_GS; var = 1; break; case 2: kind = K_O2; var = 0; break; case 3: kind = K_GS; var = 2; break; case 4: kind = K_O4; var = 0; break;
                     case 5: kind = K_GS; var = 3; break; case 6: kind = K_NORM; var = 1; break; case 7: kind = K_F1; var = 0; break; default: kind = K_GS; var = 4; break; }
    }
}

__global__ void __launch_bounds__(512, 2) mega(Params p_arg) {
    cg::grid_group grid = cg::this_grid();
    const int ph_lo = get_params()->ph_lo, ph_hi = get_params()->ph_hi;
    volatile LAS unsigned* xb_st = (volatile LAS unsigned*)((LAS unsigned char*)g_shm + (LDS_BYTES - 16));
    XcdBarrier xb; xb.bar = (unsigned*)(get_params()->ws + WS_BAR); xb.x = 0; xb.st = xb_st;
    if (ph_hi - ph_lo > 1) { if (threadIdx.x == 0) { xb_st[0] = 0u; xb_st[1] = 0u; } __syncthreads(); xb = xcd_barrier_post(xb.bar, xb_st); }
    for (int ph = ph_lo; ph < ph_hi; ++ph) {
        PRef p = *get_params();
        unsigned char* shm = g_shm;
        LAS unsigned char* lds = (LAS unsigned char*)g_shm;
        const int wg = bidx(), G = gdim();
        unsigned char* ws = p.ws;
        int kind, l, var; decode_phase(ph, kind, l, var);
        const int j = l >> 1;
        const int nrep = (kind == REP_KIND && (REP_VAR < 0 || var == REP_VAR)) ? 1 + REP_N : 1;
        for (int rep = 0; rep < nrep; ++rep)
        switch (kind) {
        case K_PREP: phase_prep(p, shm); break;
        case K_NORM: phase_norm(p, l, var); break;
        case K_GS: {
            const int nsub = var == 2 ? 3 : 1;
            if (var == 0) phase_zgemm(p, j, shm);
            for (int gi = 0; gi < nsub; ++gi) {
                pg8::Gemm g; pg8::EpiStore E; int c = wg, GG = G, ns = 1, ksub = 0;
                if (var == 3) { g = {(const bf16_t*)(ws + WS_MIX), (const bf16_t*)(ws + ((l & 1) ? WS_WOUTO : WS_WOUTE)) + (size_t)j * 1024 * 1024, T, 1024, 512, 1024}; E = {(bf16_t*)(ws + WS_P), 1024, 1024, (size_t)T * 1024}; ns = 2; ksub = 512; }
                else if (var == 4) { g = {(const bf16_t*)(ws + WS_ACT), (const bf16_t*)(ws + WS_WFO) + (size_t)l * 1024 * 2816, T, 1024, 1408, 2816}; E = {(bf16_t*)(ws + WS_P), 1024, 1024, (size_t)T * 1024}; ns = 2; ksub = 1408; }
                else if (var == 0) { g = {(const bf16_t*)(ws + WS_H), (const bf16_t*)(ws + WS_WINE) + (size_t)j * 2560 * 1024, T, 2560, 1024, 1024}; E = {(bf16_t*)(ws + WS_PROJ), 2560, 2560, 0}; }
                else if (var == 1) { g = {(const bf16_t*)(ws + WS_H), (const bf16_t*)(ws + WS_WINO) + (size_t)j * 2048 * 1024, T, 2048, 1024, 1024}; E = {(bf16_t*)(ws + WS_PROJ), PLO, 1984, 0}; }
                else {
                    int off;
                    if (gi == 0) { g = {(const bf16_t*)(ws + WS_CQN), (const bf16_t*)(ws + WS_WQB) + (size_t)j * 768 * 256, T, 768, 256, 256}; E = {(bf16_t*)(ws + WS_QMLA), 768, 768, 0}; off = 0; }
                    else if (gi == 1) { g = {(const bf16_t*)(ws + WS_CKV) + (size_t)j * TK * 256, (const bf16_t*)(ws + WS_WKVK) + (size_t)j * 512 * 256, TK, 512, 256, 256}; E = {(bf16_t*)(ws + WS_KNOPE), 512, 512, 0}; off = 72; }
                    else { g = {(const bf16_t*)(ws + WS_WKVV) + (size_t)j * 512 * 256, (const bf16_t*)(ws + WS_CKV) + (size_t)j * TK * 256, 512, TK, 256, 256}; E = {(bf16_t*)(ws + WS_VTM), TK, TK, 0}; off = 128; }
                    if (G >= 184) { c = wg - off; GG = 256; }
                }
                pg8::Order S; S.init(g.M, g.N, GG, c, ns, ksub);
                pg8::gemm_phase(lds, g, S, E);
            }
            if (var == 4 && l < 3 && G == 256) { if (wg >= 192) conv_layer(p, l + 1, wg - 192, 64, (float*)shm, 2); }
        } break;
        case K_E2: {
            unsigned* q = (unsigned*)(ws + WS_BAR) + 16 + l * 4; volatile LAS unsigned* slot = (volatile LAS unsigned*)((LAS unsigned char*)g_shm + (LDS_BYTES - 32));
            for (;;) { const int it = next_item(q, slot); if (it >= 880) break; if (it < 112) gqa_prep(p, j, it, shm); else gla_pass_a(p, j, it - 112, shm); }
        } break;
        case K_E3: {
            unsigned* q = (unsigned*)(ws + WS_BAR) + 17 + l * 4; volatile LAS unsigned* slot = (volatile LAS unsigned*)((LAS unsigned char*)g_shm + (LDS_BYTES - 32));
            for (;;) { const int it = next_item(q, slot); if (it >= 768) break;
                if (it < 128 || (it >= 256 && it < 512)) gla_pass_b(p, j, it < 128 ? 256 + it : it - 256, shm); else gqa_attn_item(p, it < 256 ? it - 128 : it - 384, shm); }
        } break;
        case K_O2:
            for (int it = wg; it < 384; it += G) odd_prep(p, j, it, shm);
            break;
        case K_O4: {
            unsigned* q = (unsigned*)(ws + WS_BAR) + 18 + l * 4; volatile LAS unsigned* slot = (volatile LAS unsigned*)((LAS unsigned char*)g_shm + (LDS_BYTES - 32));
            for (;;) { const int it = next_item(q, slot); if (it >= 576) break;
                if (it < 192) hyena_conv(p, j, it < 64 ? 1 : 0, it < 64 ? 0 : (it - 64) >> 6, it < 64 ? it : (it - 64) & 63, shm);
                else mla_attn_item(p, j, it - 192, shm); }
        } break;
        default: {
            pg8::Gemm g{(const bf16_t*)(ws + WS_H), (const bf16_t*)(ws + WS_WFI) + (size_t)l * 5632 * 1024, T, 5632, 1024, 1024};
            pg8::Order S; S.init(T, 5632, G, wg); pg8::EpiSwiglu E{(bf16_t*)(ws + WS_ACT)};
            pg8::gemm_phase(lds, g, S, E);
            if (l < 3) {
                const int nlast = 528 - 2 * G;
                if (G == 256 && nlast > 0) { if (wg >= nlast) conv_layer(p, l + 1, wg - nlast, G - nlast, (float*)shm, 1); }
                else conv_layer(p, l + 1, wg, G, (float*)shm); }
        } break;
        }
        if (ph + 1 < ph_hi) { if (USE_CG_SYNC || ph_hi > 100000) grid.sync(); else xcd_barrier(xb); }
        for (int es = 0; es < EXTRA_SYNC; ++es) xcd_barrier(xb);
    }
}

extern "C" void kernel_launch(void* const* d_in, const int* in_sizes, int n_in, void* d_out, int out_size, void* d_ws, size_t ws_size, hipStream_t stream) {
    static int grid = 0;
    if (grid == 0) {
        if (n_in != NIN || ws_size < WS_END) { fprintf(stderr, "kernel_launch: unexpected n_in %d / ws_size %zu (need %zu)\n", n_in, ws_size, (size_t)WS_END); grid = -1; return; }
        int dev = 0, cus = 0, per_cu = 0;
        hipGetDevice(&dev); hipDeviceGetAttribute(&cus, hipDeviceAttributeMultiprocessorCount, dev);
        if (hipFuncSetAttribute((const void*)mega, hipFuncAttributeMaxDynamicSharedMemorySize, LDS_BYTES) != hipSuccess) { fprintf(stderr, "kernel_launch: hipFuncSetAttribute failed\n"); grid = -1; return; }
        if (hipOccupancyMaxActiveBlocksPerMultiprocessor(&per_cu, (const void*)mega, 512, LDS_BYTES) != hipSuccess || per_cu < 1) { fprintf(stderr, "kernel_launch: occupancy query says %d\n", per_cu); per_cu = 1; }
        (void)hipGetLastError();
        grid = cus;
        if (grid > 256) grid = 256;
    }
    if (grid < 0) return;
    Params p{};
    for (int i = 0; i < NIN; ++i) p.in[i] = (const float*)d_in[i];
    p.out = (float*)d_out; p.ws = (unsigned char*)d_ws;
#if MULTI_LAUNCH
    for (int ph = 0; ph < N_PHASES; ++ph) { p.ph_lo = ph; p.ph_hi = ph + 1; hipLaunchKernelGGL(mega, dim3(grid), dim3(512), LDS_BYTES, stream, p); }
#else
    p.ph_lo = 0; p.ph_hi = N_PHASES;
    if (hipMemsetAsync((unsigned char*)d_ws + WS_BAR, 0, 16384, stream) != hipSuccess) { fprintf(stderr, "kernel_launch: memset of barrier words failed\n"); return; }
    void* args[] = {&p};
    hipError_t e = hipLaunchCooperativeKernel((const void*)mega, dim3(grid), dim3(512), args, LDS_BYTES, stream);
    if (e != hipSuccess) fprintf(stderr, "cooperative launch failed: %s (grid %d)\n", hipGetErrorString(e), grid);
#endif
}
```
